# Optimizing an MI355X kernel written in HIP

```python
import math
import numpy as np
import jax
import jax.numpy as jnp
from jax import lax

D_MODEL = 1024
BATCH = 8
SEQ = 2048
DEPTH = 1
DEC_BATCH = 32
DEC_SEQ = 1
PAST_LEN = 16384
PAGE_SIZE = 128

NSA_HEADS = 8
NSA_KV_HEADS = 2
NSA_HPG = NSA_HEADS // NSA_KV_HEADS
HEAD_DIM = 64
NSA_WIDTH = NSA_HEADS * HEAD_DIM
CMP_BLOCK = 32
CMP_STRIDE = 16
CMP_HID = 256
SEL_BLOCK = 64
SEL_TOPN = 16
WINDOW = 512
Q_BLOCK = 64
MLSTM_HEADS = 4
MLSTM_DK = 128
MLSTM_DV = 128
MLSTM_WIDTH = MLSTM_HEADS * MLSTM_DV
MLSTM_CHUNK = 64
FFN_HIDDEN = ((8 * D_MODEL + 3 * 256 - 1) // (3 * 256)) * 256
REL_BUCKETS = 32
REL_MAX_DIST = 1024
N_KV_GROUPS = 6
OFF_QA = 0
OFF_KVA = OFF_QA + NSA_WIDTH
OFF_GA = OFF_KVA + N_KV_GROUPS * NSA_KV_HEADS * HEAD_DIM
OFF_QB = OFF_GA + 3 * NSA_HEADS
OFF_KB = OFF_QB + MLSTM_HEADS * MLSTM_DK
OFF_VB = OFF_KB + MLSTM_HEADS * MLSTM_DK
OFF_IFB = OFF_VB + MLSTM_WIDTH
OFF_OB = OFF_IFB + 2 * MLSTM_HEADS
OFF_MG = OFF_OB + MLSTM_WIDTH
N_IN = OFF_MG + 2 * D_MODEL
NEG = -1e30
BIG = 1e9
EPS = 1e-6

kernel_name = 'nsa_mlstm_gated_hybrid_step'


def rmsnorm(x, g):
    xf = x.astype(jnp.float32)
    y = xf * lax.rsqrt(jnp.mean(xf * xf, axis=-1, keepdims=True) + EPS)
    return (y * g.astype(jnp.float32)).astype(x.dtype)


def modulate(h, shift, scale):
    return h * (1.0 + scale[:, None, :]) + shift[:, None, :]


def head_norm(h, g):
    hf = h.astype(jnp.float32)
    mu = jnp.mean(hf, axis=-1, keepdims=True)
    var = jnp.mean(jnp.square(hf - mu), axis=-1, keepdims=True)
    y = (hf - mu) * lax.rsqrt(var + EPS)
    return y.reshape(h.shape[:2] + (-1,)) * g.astype(jnp.float32)


def rel_bucket(dist):
    exact = REL_BUCKETS // 2
    d = jnp.maximum(dist, 0)
    df = jnp.maximum(d, exact).astype(jnp.float32)
    large = exact + (jnp.log(df / exact) / math.log(REL_MAX_DIST / exact) * (REL_BUCKETS - exact)).astype(jnp.int32)
    large = jnp.minimum(large, REL_BUCKETS - 1)
    return jnp.where(d < exact, d, large)


def masked_softmax(s, mask):
    s = jnp.where(mask, s.astype(jnp.float32), NEG)
    m = jnp.max(s, axis=-1, keepdims=True)
    e = jnp.where(mask, jnp.exp(s - m), 0.0)
    return e / jnp.maximum(jnp.sum(e, axis=-1, keepdims=True), 1e-30)


def compress(kv, pe, w1, w2):
    b, t = kv.shape[:2]
    r = CMP_BLOCK // CMP_STRIDE
    n_c = (t - CMP_BLOCK) // CMP_STRIDE + 1
    pieces = kv[:, :(n_c + r - 1) * CMP_STRIDE].reshape(b, n_c + r - 1, CMP_STRIDE, NSA_KV_HEADS, HEAD_DIM)
    pe_r = pe.reshape(r, CMP_STRIDE, HEAD_DIM)
    w1_r = w1.reshape(r, CMP_STRIDE, HEAD_DIM, CMP_HID)
    hid = sum(jnp.einsum('bncgd,cdf->bngf', pieces[:, p:p + n_c] + pe_r[p][:, None, :], w1_r[p]) for p in range(r))
    return jnp.einsum('bngf,fd->bngd', jax.nn.gelu(hid), w2)


def compress_kv(k, v, p):
    kc = compress(k, p['cmp_pe'][0], p['cmp_w1'][0], p['cmp_w2'][0])
    vc = compress(v, p['cmp_pe'][1], p['cmp_w1'][1], p['cmp_w2'][1])
    cend = jnp.arange(kc.shape[1]) * CMP_STRIDE + CMP_BLOCK - 1
    return kc, vc, cend


def block_cover(n_c, n_sel):
    i = np.arange(n_c)[:, None]
    j = np.arange(n_sel)[None, :]
    start = i * CMP_STRIDE
    end = start + CMP_BLOCK - 1
    return ((start <= j * SEL_BLOCK + SEL_BLOCK - 1) & (end >= j * SEL_BLOCK)).astype(np.float32)


def sel_blocks(k):
    b, t = k.shape[:2]
    n_sel = -(-t // SEL_BLOCK)
    k = jnp.pad(k, ((0, 0), (0, n_sel * SEL_BLOCK - t), (0, 0), (0, 0)))
    return jnp.transpose(k.reshape(b, n_sel, SEL_BLOCK, NSA_KV_HEADS, HEAD_DIM), (0, 3, 1, 2, 4))


def nsa_core(q, qpos, gates, kc, vc, cend, ks_blk, vs_blk, kw, vw, wpos, rel_bias):
    b, tq = q.shape[:2]
    n_c = kc.shape[1]
    n_sel = ks_blk.shape[2]
    qg = q.reshape(b, tq, NSA_KV_HEADS, NSA_HPG, HEAD_DIM)
    table = rel_bias.reshape(REL_BUCKETS, NSA_KV_HEADS, NSA_HPG)
    dist_c = qpos[:, None] - cend[None, :]
    bias_c = jnp.transpose(table[rel_bucket(dist_c)], (0, 2, 3, 1))
    s_c = jnp.einsum('btghd,bngd->btghn', qg, kc) + bias_c
    p_c = masked_softmax(s_c, (dist_c >= 0)[:, None, None, :])
    o_c = jnp.einsum('btghn,bngd->btghd', p_c.astype(vc.dtype), vc)
    imp = jnp.einsum('btgn,nj->btgj', jnp.sum(p_c, axis=3), jnp.asarray(block_cover(n_c, n_sel)))
    jblk = jnp.arange(n_sel)
    cur = (qpos // SEL_BLOCK)[:, None]
    forced = ((jblk == 0) | (jblk == cur) | (jblk == cur - 1))[:, None, :]
    valid = (jblk * SEL_BLOCK <= qpos[:, None])[:, None, :]
    score = jnp.where(valid, jnp.where(forced, BIG, imp), NEG)
    _, idx = lax.top_k(score, min(SEL_TOPN, n_sel))
    bi = jnp.arange(b)[:, None, None, None]
    gi = jnp.arange(NSA_KV_HEADS)[None, None, :, None]
    k_sel = ks_blk[bi, gi, idx].reshape(b, tq, NSA_KV_HEADS, -1, HEAD_DIM)
    v_sel = vs_blk[bi, gi, idx].reshape(b, tq, NSA_KV_HEADS, -1, HEAD_DIM)
    kpos = (idx[..., None] * SEL_BLOCK + jnp.arange(SEL_BLOCK)).reshape(b, tq, NSA_KV_HEADS, -1)
    dist_s = qpos[None, :, None, None] - kpos
    bias_s = jnp.swapaxes(jnp.transpose(table, (1, 0, 2))[gi, rel_bucket(dist_s)], -1, -2)
    s_s = jnp.einsum('btghd,btgkd->btghk', qg, k_sel) + bias_s
    p_s = masked_softmax(s_s, (dist_s >= 0)[:, :, :, None, :])
    o_s = jnp.einsum('btghk,btgkd->btghd', p_s.astype(v_sel.dtype), v_sel)
    dist_w = qpos[:, None] - wpos[None, :]
    mask_w = ((dist_w >= 0) & (dist_w < WINDOW) & (wpos >= 0)[None, :])[:, None, None, :]
    bias_w = jnp.transpose(table[rel_bucket(dist_w)], (0, 2, 3, 1))
    s_w = jnp.einsum('btghd,bsgd->btghs', qg, kw) + bias_w
    p_w = masked_softmax(s_w, mask_w)
    o_w = jnp.einsum('btghs,bsgd->btghd', p_w.astype(vw.dtype), vw)
    shp = (b, tq, NSA_HEADS, HEAD_DIM)
    return gates[..., 0:1] * o_c.reshape(shp) + gates[..., 1:2] * o_s.reshape(shp) + gates[..., 2:3] * o_w.reshape(shp)


def mlstm_chunkwise(q, k, v, i_pre, f_pre, c0, n0, m0):
    b, t, h, dk = q.shape
    L = MLSTM_CHUNK if t % MLSTM_CHUNK == 0 else t
    nc = t // L

    def chunks(a):
        a = a.astype(jnp.float32).reshape((b, nc, L) + a.shape[2:])
        return jnp.moveaxis(jnp.moveaxis(a, 1, 0), 3, 2)

    causal = jnp.tril(jnp.ones((L, L), dtype=bool))

    def step(carry, inp):
        c_st, n_st, m_st = carry
        qc, kc, vc, ic, fc = inp
        bcum = jnp.cumsum(jax.nn.log_sigmoid(fc), axis=-1)
        a_inter = bcum + m_st[..., None]
        dmat = jnp.where(causal, bcum[..., :, None] - bcum[..., None, :] + ic[..., None, :], NEG)
        m_t = jnp.maximum(a_inter, jnp.max(dmat, axis=-1))
        w_inter = jnp.exp(a_inter - m_t)
        sw = jnp.einsum('bhld,bhsd->bhls', qc, kc) * jnp.exp(dmat - m_t[..., None])
        num = w_inter[..., None] * jnp.einsum('bhld,bhde->bhle', qc, c_st) + jnp.einsum('bhls,bhse->bhle', sw, vc)
        den = w_inter * jnp.einsum('bhld,bhd->bhl', qc, n_st) + jnp.sum(sw, axis=-1)
        h_out = num / jnp.maximum(jnp.abs(den), jnp.exp(-m_t))[..., None]
        b_last = bcum[..., -1]
        g_s = b_last[..., None] - bcum + ic
        m_new = jnp.maximum(b_last + m_st, jnp.max(g_s, axis=-1))
        w_c = jnp.exp(b_last + m_st - m_new)
        w_s = jnp.exp(g_s - m_new[..., None])
        c_new = w_c[..., None, None] * c_st + jnp.einsum('bhl,bhld,bhle->bhde', w_s, kc, vc)
        n_new = w_c[..., None] * n_st + jnp.einsum('bhl,bhld->bhd', w_s, kc)
        return (c_new, n_new, m_new), h_out

    xs = (chunks(q), chunks(k) * (dk ** -0.5), chunks(v), chunks(i_pre), chunks(f_pre))
    init = (c0.astype(jnp.float32), n0.astype(jnp.float32), m0.astype(jnp.float32))
    (c_f, n_f, m_f), hs = lax.scan(step, init, xs)
    return jnp.transpose(hs, (1, 0, 3, 2, 4)).reshape(b, t, h, -1), c_f, n_f, m_f


def mixer_input(x, c, p):
    b, t = x.shape[:2]
    mod = (c @ p['w_ada'] + p['b_ada']).reshape(b, 6, D_MODEL)
    u = modulate(rmsnorm(x, p['norm_mix_g']), mod[:, 0], mod[:, 1])
    z = u @ p['w_in']
    q_a = z[..., OFF_QA:OFF_KVA].reshape(b, t, NSA_HEADS, HEAD_DIM) * (HEAD_DIM ** -0.5)
    kv_a = z[..., OFF_KVA:OFF_GA].reshape(b, t, N_KV_GROUPS, NSA_KV_HEADS, HEAD_DIM)
    g_a = jax.nn.sigmoid(z[..., OFF_GA:OFF_QB].reshape(b, t, NSA_HEADS, 3))
    q_b = z[..., OFF_QB:OFF_KB].reshape(b, t, MLSTM_HEADS, MLSTM_DK)
    k_b = z[..., OFF_KB:OFF_VB].reshape(b, t, MLSTM_HEADS, MLSTM_DK)
    v_b = z[..., OFF_VB:OFF_IFB].reshape(b, t, MLSTM_HEADS, MLSTM_DV)
    if_b = (z[..., OFF_IFB:OFF_OB] + p['mlstm_gate_b']).reshape(b, t, 2, MLSTM_HEADS)
    o_b = jax.nn.sigmoid(z[..., OFF_OB:OFF_MG])
    g_m = jax.nn.sigmoid(z[..., OFF_MG:N_IN]).reshape(b, t, 2, D_MODEL)
    return mod, q_a, kv_a, g_a, q_b, k_b, v_b, if_b, o_b, g_m


def mixer_output_and_ffn(x, mod, o_a, h_b, o_b, g_m, p):
    b, t = x.shape[:2]
    br_a = o_a.reshape(b, t, NSA_WIDTH).astype(x.dtype) @ p['w_branch_a']
    br_b = (o_b.astype(jnp.float32) * head_norm(h_b, p['mlstm_norm_g'])).astype(x.dtype) @ p['w_branch_b']
    mixed = g_m[:, :, 0] * br_a + g_m[:, :, 1] * br_b
    x = x + mod[:, 2][:, None, :] * (mixed @ p['w_out'])
    u = modulate(rmsnorm(x, p['norm_ffn_g']), mod[:, 3], mod[:, 4])
    gate, up = jnp.split(u @ p['w_ffn_in'], 2, axis=-1)
    return x + mod[:, 5][:, None, :] * ((jax.nn.silu(gate) * up) @ p['w_ffn_out'])


def prompt_layer(x, c, rel_bias, p):
    b, t = x.shape[:2]
    mod, q_a, kv_a, g_a, q_b, k_b, v_b, if_b, o_b, g_m = mixer_input(x, c, p)
    kc, vc, cend = compress_kv(kv_a[:, :, 0], kv_a[:, :, 1], p)
    ks_blk = sel_blocks(kv_a[:, :, 2])
    vs_blk = sel_blocks(kv_a[:, :, 3])
    pad = ((0, 0), (WINDOW, 0), (0, 0), (0, 0))
    kw_pad = jnp.pad(kv_a[:, :, 4], pad)
    vw_pad = jnp.pad(kv_a[:, :, 5], pad)
    band = WINDOW + Q_BLOCK

    def query_block(j):
        q0 = j * Q_BLOCK
        return nsa_core(lax.dynamic_slice_in_dim(q_a, q0, Q_BLOCK, axis=1), q0 + jnp.arange(Q_BLOCK),
                        lax.dynamic_slice_in_dim(g_a, q0, Q_BLOCK, axis=1), kc, vc, cend, ks_blk, vs_blk,
                        lax.dynamic_slice_in_dim(kw_pad, q0, band, axis=1),
                        lax.dynamic_slice_in_dim(vw_pad, q0, band, axis=1),
                        q0 - WINDOW + jnp.arange(band), rel_bias)

    o_a = lax.map(query_block, jnp.arange(t // Q_BLOCK))
    o_a = jnp.moveaxis(o_a, 0, 1).reshape(b, t, NSA_HEADS, HEAD_DIM)
    c0 = jnp.zeros((b, MLSTM_HEADS, MLSTM_DK, MLSTM_DV), jnp.float32)
    n0 = jnp.zeros((b, MLSTM_HEADS, MLSTM_DK), jnp.float32)
    m0 = jnp.zeros((b, MLSTM_HEADS), jnp.float32)
    h_b, c_new, n_new, m_new = mlstm_chunkwise(q_b, k_b, v_b, if_b[:, :, 0], if_b[:, :, 1], c0, n0, m0)
    y = mixer_output_and_ffn(x, mod, o_a, h_b, o_b, g_m, p)
    keep = min(WINDOW, t)
    return y, kv_a[:, :, :4], kv_a[:, t - keep:, 4:], c_new, n_new, m_new


def sample_layer(x, c, kv_pages, page_table, win_buf, c0, n0, m0, rel_bias, p):
    b, t = x.shape[:2]
    mod, q_a, kv_a, g_a, q_b, k_b, v_b, if_b, o_b, g_m = mixer_input(x, c, p)
    past = kv_pages[page_table]
    past = past.reshape((b, -1) + past.shape[3:])
    past_len = past.shape[1]
    full = jnp.concatenate([past, kv_a[:, :, :4].astype(past.dtype)], axis=1)
    kc, vc, cend = compress_kv(full[:, :, 0], full[:, :, 1], p)
    win = jnp.concatenate([win_buf, kv_a[:, :, 4:].astype(win_buf.dtype)], axis=1)
    wpos = past_len - win_buf.shape[1] + jnp.arange(win.shape[1])
    qpos = past_len + jnp.arange(t)
    o_a = nsa_core(q_a, qpos, g_a, kc, vc, cend, sel_blocks(full[:, :, 2]), sel_blocks(full[:, :, 3]),
                   win[:, :, 0], win[:, :, 1], wpos, rel_bias)
    h_b, c_new, n_new, m_new = mlstm_chunkwise(q_b, k_b, v_b, if_b[:, :, 0], if_b[:, :, 1], c0, n0, m0)
    y = mixer_output_and_ffn(x, mod, o_a, h_b, o_b, g_m, p)
    keep = min(WINDOW, win.shape[1])
    return y, kv_a[:, :, :4], win[:, win.shape[1] - keep:], c_new, n_new, m_new


def final_norm(x, c, w, bvec, g):
    mod = (c @ w + bvec).reshape(c.shape[0], 2, D_MODEL)
    return modulate(rmsnorm(x, g), mod[:, 0], mod[:, 1])


def setup_inputs(seed: int = 0) -> dict:
    key = jax.random.key(seed)
    k = jax.random.split(key, 30)
    f32 = jnp.float32

    def nrm(kk, shape, scale):
        return scale * jax.random.normal(kk, shape, f32)

    d = D_MODEL
    n_pages = PAST_LEN // PAGE_SIZE
    n_used = DEC_BATCH * n_pages
    n_pool = n_used + (n_used + 3) // 4
    wb = min(WINDOW, PAST_LEN)
    page_table = jax.random.permutation(k[0], n_pool)[:n_used].reshape(DEC_BATCH, n_pages).astype(jnp.int32)
    gate_b = jnp.concatenate([nrm(k[1], (DEPTH, MLSTM_HEADS), 0.1),
                              jnp.linspace(3.0, 6.0, MLSTM_HEADS, dtype=f32)[None, :] + nrm(k[2], (DEPTH, MLSTM_HEADS), 0.1)], axis=-1)
    return {
        'x_prompt': nrm(k[3], (BATCH, SEQ, d), 1.0),
        'x_sample': nrm(k[4], (DEC_BATCH, DEC_SEQ, d), 1.0),
        'c_prompt': nrm(k[5], (BATCH, d), 1.0),
        'c_sample': nrm(k[6], (DEC_BATCH, d), 1.0),
        'cache_nsa_kv': nrm(k[7], (DEPTH, n_pool, PAGE_SIZE, 4, NSA_KV_HEADS, HEAD_DIM), 1.0),
        'cache_nsa_win': nrm(k[8], (DEPTH, DEC_BATCH, wb, 2, NSA_KV_HEADS, HEAD_DIM), 1.0),
        'state_mlstm_C': nrm(k[9], (DEPTH, DEC_BATCH, MLSTM_HEADS, MLSTM_DK, MLSTM_DV), 0.1),
        'state_mlstm_n': nrm(k[10], (DEPTH, DEC_BATCH, MLSTM_HEADS, MLSTM_DK), 0.1),
        'state_mlstm_m': nrm(k[11], (DEPTH, DEC_BATCH, MLSTM_HEADS), 1.0),
        'page_table': page_table,
        'rel_bias': nrm(k[12], (REL_BUCKETS, NSA_HEADS), 0.5),
        'w_ada': nrm(k[13], (DEPTH, d, 6 * d), 0.3 * d ** -0.5),
        'b_ada': nrm(k[14], (DEPTH, 6 * d), 0.02),
        'norm_mix_g': 1.0 + nrm(k[15], (DEPTH, d), 0.02),
        'norm_ffn_g': 1.0 + nrm(k[16], (DEPTH, d), 0.02),
        'w_in': nrm(k[17], (DEPTH, d, N_IN), d ** -0.5),
        'mlstm_gate_b': gate_b,
        'cmp_pe': nrm(k[18], (DEPTH, 2, CMP_BLOCK, HEAD_DIM), 0.1),
        'cmp_w1': nrm(k[19], (DEPTH, 2, CMP_BLOCK, HEAD_DIM, CMP_HID), (CMP_BLOCK * HEAD_DIM) ** -0.5),
        'cmp_w2': nrm(k[20], (DEPTH, 2, CMP_HID, HEAD_DIM), CMP_HID ** -0.5),
        'mlstm_norm_g': 1.0 + nrm(k[21], (DEPTH, MLSTM_WIDTH), 0.02),
        'w_branch_a': nrm(k[22], (DEPTH, NSA_WIDTH, d), NSA_WIDTH ** -0.5),
        'w_branch_b': nrm(k[23], (DEPTH, MLSTM_WIDTH, d), MLSTM_WIDTH ** -0.5),
        'w_out': nrm(k[24], (DEPTH, d, d), d ** -0.5),
        'w_ffn_in': nrm(k[25], (DEPTH, d, 2 * FFN_HIDDEN), d ** -0.5),
        'w_ffn_out': nrm(k[26], (DEPTH, FFN_HIDDEN, d), FFN_HIDDEN ** -0.5),
        'w_ada_final': nrm(k[27], (d, 2 * d), 0.3 * d ** -0.5),
        'b_ada_final': nrm(k[28], (2 * d,), 0.02),
        'norm_final_g': 1.0 + nrm(k[29], (d,), 0.02),
    }


def reference(x_prompt, x_sample, c_prompt, c_sample, cache_nsa_kv, cache_nsa_win, state_mlstm_C, state_mlstm_n,
              state_mlstm_m, page_table, rel_bias, w_ada, b_ada, norm_mix_g, norm_ffn_g, w_in, mlstm_gate_b,
              cmp_pe, cmp_w1, cmp_w2, mlstm_norm_g, w_branch_a, w_branch_b, w_out, w_ffn_in, w_ffn_out,
              w_ada_final, b_ada_final, norm_final_g):
    xp = x_prompt
    xs = x_sample
    st_p = []
    st_s = []
    for l in range(DEPTH):
        p = {'w_ada': w_ada[l], 'b_ada': b_ada[l], 'norm_mix_g': norm_mix_g[l], 'norm_ffn_g': norm_ffn_g[l],
             'w_in': w_in[l], 'mlstm_gate_b': mlstm_gate_b[l], 'cmp_pe': cmp_pe[l], 'cmp_w1': cmp_w1[l],
             'cmp_w2': cmp_w2[l], 'mlstm_norm_g': mlstm_norm_g[l], 'w_branch_a': w_branch_a[l],
             'w_branch_b': w_branch_b[l], 'w_out': w_out[l], 'w_ffn_in': w_ffn_in[l], 'w_ffn_out': w_ffn_out[l]}
        xp, kv_pl, win_pl, c_pl, n_pl, m_pl = prompt_layer(xp, c_prompt, rel_bias, p)
        xs, kv_sl, win_sl, c_sl, n_sl, m_sl = sample_layer(xs, c_sample, cache_nsa_kv[l], page_table, cache_nsa_win[l],
                                                          state_mlstm_C[l], state_mlstm_n[l], state_mlstm_m[l], rel_bias, p)
        st_p.append((kv_pl, win_pl, c_pl, n_pl, m_pl))
        st_s.append((kv_sl, win_sl, c_sl, n_sl, m_sl))
    kv_p, win_p, c_p, n_p, m_p = [jnp.stack(a) for a in zip(*st_p)]
    kv_s, win_s, c_s, n_s, m_s = [jnp.stack(a) for a in zip(*st_s)]
    y_prompt = final_norm(xp, c_prompt, w_ada_final, b_ada_final, norm_final_g)
    y_sample = final_norm(xs, c_sample, w_ada_final, b_ada_final, norm_final_g)
    return (y_prompt, y_sample, kv_p, kv_s, win_p, win_s, c_p, n_p, m_p, c_s, n_s, m_s)
```

```cpp
#include <hip/hip_runtime.h>
#include <cstdio>
#include <cstdint>

#define LAS __attribute__((address_space(3)))
#define GAS __attribute__((address_space(1)))
#define DI __device__ __forceinline__
typedef unsigned short bf16_t;
typedef short bf16x8 __attribute__((ext_vector_type(8)));
typedef short s16x4 __attribute__((ext_vector_type(4)));
typedef short v4i16_t __attribute__((ext_vector_type(4)));
typedef float f32x4 __attribute__((ext_vector_type(4)));
typedef float f32x2 __attribute__((ext_vector_type(2)));
typedef float f32x16 __attribute__((ext_vector_type(16)));
typedef unsigned u32x4 __attribute__((ext_vector_type(4)));
typedef unsigned u32x2 __attribute__((ext_vector_type(2)));
typedef __bf16 bf16x2_t __attribute__((ext_vector_type(2)));

DI float bf2f(unsigned v) { return __builtin_bit_cast(float, v << 16); }
DI unsigned pk2(float lo, float hi) { f32x2 v = {lo, hi}; bf16x2_t b = __builtin_convertvector(v, bf16x2_t); return __builtin_bit_cast(unsigned, b); }
DI float sigmoidf_(float x) { return __builtin_amdgcn_rcpf(1.f + __builtin_amdgcn_exp2f(x * -1.4426950408889634f)); }
DI float wave_sum(float v) {
#pragma unroll
    for (int o = 1; o < 64; o <<= 1) v += __shfl_xor(v, o);
    return v;
}
DI float wave_max(float v) {
#pragma unroll
    for (int o = 1; o < 64; o <<= 1) v = fmaxf(v, __shfl_xor(v, o));
    return v;
}

constexpr int D = 1024, NBATCH = 8, T = 2048, MPR = NBATCH * T, NSMP = 32, MREAL = MPR + NSMP, MP = 16640;
constexpr int NIN = 5408, NZ = 5632, FFH = 2816, NFF = 2 * FFH;
constexpr int PAST = 16384, NPAGES = 128, PAGE = 128;
constexpr int AROWS_P = 2048, AROWS_S = 65536, AROWS = AROWS_P + AROWS_S;
constexpr float LOG2E = 1.4426950408889634f;
constexpr float QSCALE = 0.125f * LOG2E;
constexpr float EPS = 1e-6f;

constexpr size_t O_Y = 0, O_YS = 16777216, O_KVP = 16809984, O_KVS = 25198592, O_WINP = 25214976, O_WINS = 26263552, O_CP = 30457856, O_NP = 30982144, O_MP = 30986240,
                 O_CS = 30986272, O_NS = 33083424, O_MS = 33099808, O_END = 33099936;

constexpr size_t al256(size_t x) { return (x + 255) & ~(size_t)255; }
constexpr size_t WS_CTL = 0, CTL_ZERO_BYTES = 1u << 20;
constexpr size_t WS_WIN_T = CTL_ZERO_BYTES;
constexpr size_t WS_WBR_T = WS_WIN_T + (size_t)NZ * 1024 * 2;
constexpr size_t WS_WOUT_T = WS_WBR_T + (size_t)1024 * 1024 * 2;
constexpr size_t WS_WFI_T = WS_WOUT_T + (size_t)1024 * 1024 * 2;
constexpr size_t WS_WFO_T = WS_WFI_T + (size_t)NFF * 1024 * 2;
constexpr size_t WS_W1C_T = WS_WFO_T + (size_t)1024 * FFH * 2;
constexpr size_t WS_W1P_T = WS_W1C_T + (size_t)2 * 256 * 2048 * 2;
constexpr size_t WS_W2C_T = WS_W1P_T + (size_t)2 * 512 * 1024 * 2;
constexpr size_t WS_MOD = WS_W2C_T + (size_t)2 * 64 * 256 * 2;
constexpr size_t WS_MODF = WS_MOD + (size_t)40 * 6144 * 4;
constexpr size_t WS_CBIAS = WS_MODF + (size_t)40 * 2048 * 4;
constexpr size_t WS_U = al256(WS_CBIAS + 2 * 256 * 4);
constexpr size_t WS_QA = WS_U + (size_t)MP * 1024 * 2;
constexpr size_t WS_KVB = WS_QA + (size_t)MP * 512 * 2;
constexpr size_t WS_QB = WS_KVB + (size_t)MP * 512 * 2;
constexpr size_t WS_KB = WS_QB + (size_t)MP * 512 * 2;
constexpr size_t WS_VB = WS_KB + (size_t)MP * 512 * 2;
constexpr size_t WS_OB = WS_VB + (size_t)MP * 512 * 2;
constexpr size_t WS_GM = WS_OB + (size_t)MP * 512 * 2;
constexpr size_t WS_GA = WS_GM + (size_t)MP * 2048 * 2;
constexpr size_t ABF_KIND = ((size_t)AROWS * 1024 + 4096) * 2;
constexpr size_t WS_ABF = WS_GA + (size_t)MP * 32 * 4;
constexpr size_t WS_GH = WS_ABF + 2 * ABF_KIND;
constexpr size_t WS_KC = WS_GH + (size_t)2 * AROWS_S * 512 * 2 + 4096;
constexpr size_t WS_ALPHA = WS_KC + (size_t)2 * AROWS * 64 * 2;
constexpr size_t WS_BETA = WS_ALPHA + 32 * 2048 * 4;
constexpr size_t WS_MT = WS_BETA + 32 * 2048 * 4;
constexpr size_t WS_OAHB = WS_MT + 32 * 2048 * 4;
constexpr size_t WS_MIX = WS_OAHB + (size_t)MP * 1024 * 2;
constexpr size_t WS_X1 = WS_MIX + (size_t)MP * 1024 * 2;
constexpr size_t WS_H = WS_X1 + (size_t)MP * 1024 * 4;
constexpr size_t WS_X2 = WS_H + (size_t)MP * FFH * 2;
constexpr size_t WS_NSCR = WS_X2 + (size_t)MP * 1024 * 4;
constexpr size_t WS_DC = WS_NSCR + (size_t)256 * 8 * 32 * 64 * 4;
constexpr size_t WS_DN = WS_DC + (size_t)32 * 8 * 16384 * 4;
constexpr size_t WS_MU = WS_DN + (size_t)32 * 8 * 128 * 4;
constexpr size_t WS_END = WS_MU + 4096;

constexpr int CW_QUEUE = 64;
constexpr int CW_BAR = 4096;
constexpr int CW_FLAG = 8192;
constexpr int CW_FLAG2 = 12288;
constexpr int CW_SEAMF = 16384;

namespace pg8 {
constexpr int BM = 256, BK = 64, HALF = 128, HTB = HALF * BK * 2, STAGE_BYTES = 8 * HTB, NXCD = 8, WGM = 8;
__host__ __device__ __forceinline__ int lds_byte(int r, int c) { const int st = (r >> 4) * 2 + (c >> 5), rr = r & 15, cc = c & 31, ob = rr * 64 + cc * 2; return st * 1024 + (ob ^ (((ob >> 9) & 1) << 5)); }
__host__ __device__ __forceinline__ void stage_rc(int b, int& R, int& C) { const int st = b / 1024, sb = b % 1024, swz = sb ^ (((sb >> 9) & 1) << 5); R = (st >> 1) * 16 + swz / 64; C = (st & 1) * 32 + (swz % 64) / 2; }
__host__ __device__ __forceinline__ int perm32(int rho) { const int n = rho >> 4, i = rho & 15; return 8 * (i >> 2) + 4 * n + (i & 3); }
struct Unit { int pm, pn; };
struct Gemm { const bf16_t* A; const bf16_t* Bt; int M, N, K, lda; };
struct StaticOrder {
    int nM, nN, nwg, G, c;
    __host__ __device__ void init(int M, int N, int G_, int c_) { nM = M / BM; nN = N / BM; nwg = nM * nN; G = G_; c = c_; }
    __host__ __device__ bool next(int i, Unit& u) const {
        const long L = (long)i * G + c; if (L >= nwg) return false;
        int wgid = (int)L; { const int q = nwg / NXCD, r = nwg % NXCD, xcd = wgid % NXCD, off = wgid / NXCD; wgid = (xcd < r ? xcd * (q + 1) : r * (q + 1) + (xcd - r) * q) + off; }
        const int nig = WGM * nN, gid = wgid / nig, fm = gid * WGM, gsz = (nM - fm) < WGM ? (nM - fm) : WGM;
        u.pm = fm + ((wgid % nig) % gsz); u.pn = (wgid % nig) / gsz; return true;
    }
};
template <class Epi>
__device__ __forceinline__ void gemm_phase(LAS unsigned char* lds, const Gemm g, const StaticOrder& S, const Epi& E) {
    const int tid = threadIdx.x, wid = __builtin_amdgcn_readfirstlane(tid >> 6), lane = tid & 63, wr = wid >> 2, wc = wid & 3, fr = lane & 15, fq = lane >> 4;
    const int K = g.K, nt = K / BK, lda = g.lda;
    unsigned voffA[2], voffB[2];
#pragma unroll
    for (int i = 0; i < 2; ++i) { int R, C; stage_rc(tid * 16 + i * 8192, R, C); const int Rb = (R & ~31) + perm32(R & 31);
        voffA[i] = (unsigned)(R * lda + C) * 2u; voffB[i] = (unsigned)(Rb * K + C) * 2u; }
    const size_t kstep = (size_t)(BK * 2);
    const size_t hstepA = (size_t)HALF * lda * 2, hstepB = (size_t)HALF * K * 2;
    const size_t tstepA = 2 * hstepA, tstepB = 2 * hstepB;
    const unsigned ldsw = (unsigned)wid * 1024u;
    const int aoff = lds_byte(wr * 64 + fr, fq * 8), boff = lds_byte(wc * 32 + fr, fq * 8);
#define PG8_SA(b, h) (((b) * 2 + (h)) * HTB)
#define PG8_SB(b, h) ((4 + (b) * 2 + (h)) * HTB)
#define PG8_STAGE(bufoff, gbase, voff) do { _Pragma("unroll") for (int _i = 0; _i < 2; ++_i) \
        __builtin_amdgcn_global_load_lds((const unsigned*)((const char*)(gbase) + (voff)[_i]), (LAS unsigned*)(lds + (bufoff) + ldsw + _i * 8192), 16, 0, 0); } while (0)
#define PG8_LDA(dst, b, h) do { _Pragma("unroll") for (int m = 0; m < 4; ++m) _Pragma("unroll") for (int k = 0; k < 2; ++k) dst[m][k] = *(const LAS bf16x8*)(lds + PG8_SA(b, h) + aoff + m * 2048 + k * 1024); } while (0)
#define PG8_LDB(dst, b, h) do { _Pragma("unroll") for (int n = 0; n < 2; ++n) _Pragma("unroll") for (int k = 0; k < 2; ++k) dst[n][k] = *(const LAS bf16x8*)(lds + PG8_SB(b, h) + boff + n * 2048 + k * 1024); } while (0)
#define PG8_MMA(ai, bj, At, Bt) do { __builtin_amdgcn_s_setprio(1); _Pragma("unroll") for (int m = 0; m < 4; ++m) _Pragma("unroll") for (int n = 0; n < 2; ++n) _Pragma("unroll") for (int k = 0; k < 2; ++k) \
        acc[ai][bj][m][n] = __builtin_amdgcn_mfma_f32_16x16x32_bf16(Bt[n][k], At[m][k], acc[ai][bj][m][n], 0, 0, 0); __builtin_amdgcn_s_setprio(0); } while (0)
#define PG8_WAIT_V(n) asm volatile("s_waitcnt vmcnt(" #n ")" ::: "memory")
#define PG8_WAIT_L(n) asm volatile("s_waitcnt lgkmcnt(" #n ")" ::: "memory")
#define PG8_BAR __builtin_amdgcn_s_barrier()
#define PG8_SCHED __builtin_amdgcn_sched_barrier(0)
    Unit cur, nxt; int ui = 0;
    if (!S.next(0, cur)) return;
    f32x4 acc[2][2][4][2];
#pragma unroll
    for (int a = 0; a < 2; ++a)
#pragma unroll
        for (int b = 0; b < 2; ++b)
#pragma unroll
            for (int m = 0; m < 4; ++m)
#pragma unroll
                for (int n = 0; n < 2; ++n) acc[a][b][m][n] = (f32x4){0.f, 0.f, 0.f, 0.f};
    bf16x8 At[4][2], B0[2][2], B1[2][2];
    const char* cA = (const char*)g.A + (size_t)cur.pm * tstepA; const char* cB = (const char*)g.Bt + (size_t)cur.pn * tstepB;
    PG8_STAGE(PG8_SB(0, 0), cB, voffB); PG8_STAGE(PG8_SB(0, 1), cB + hstepB, voffB); PG8_STAGE(PG8_SA(0, 0), cA, voffA); PG8_STAGE(PG8_SA(0, 1), cA + hstepA, voffA);
    if (wr == 1) PG8_BAR;
    PG8_WAIT_V(2); PG8_BAR;
    PG8_STAGE(PG8_SB(1, 0), cB + kstep, voffB); PG8_STAGE(PG8_SA(1, 0), cA + kstep, voffA); PG8_STAGE(PG8_SB(1, 1), cB + hstepB + kstep, voffB);
    PG8_WAIT_V(6); PG8_BAR;
    for (;;) {
        const bool has_next = S.next(ui + 1, nxt);
        const char* nA = has_next ? (const char*)g.A + (size_t)nxt.pm * tstepA : cA; const char* nB = has_next ? (const char*)g.Bt + (size_t)nxt.pn * tstepB : cB;
        for (int t = 0; t < nt; t += 2) {
            const bool last = (t == nt - 2);
            const char* a1 = cA + (size_t)(t + 1) * kstep;
            const char* a2 = last ? nA : cA + (size_t)(t + 2) * kstep; const char* b2 = last ? nB : cB + (size_t)(t + 2) * kstep;
            const char* a3 = a2 + kstep; const char* b3 = b2 + kstep;
            if constexpr (Epi::HAS_MID) { if (t == Epi::MID_T) E.mid(acc, cur, wr, wc, fr, fq); }
            PG8_LDB(B0, 0, 0); PG8_LDB(B1, 0, 1); PG8_SCHED; PG8_LDA(At, 0, 0); PG8_STAGE(PG8_SA(1, 1), a1 + hstepA, voffA);
            PG8_WAIT_V(8); PG8_WAIT_L(0); PG8_BAR; PG8_MMA(0, 0, At, B0); PG8_MMA(0, 1, At, B1); PG8_BAR; PG8_SCHED;
            PG8_LDA(At, 0, 1); PG8_STAGE(PG8_SB(0, 0), b2, voffB); PG8_STAGE(PG8_SB(0, 1), b2 + hstepB, voffB); PG8_STAGE(PG8_SA(0, 0), a2, voffA);
            PG8_WAIT_V(8); PG8_WAIT_L(0); PG8_BAR; PG8_MMA(1, 0, At, B0); PG8_MMA(1, 1, At, B1); PG8_BAR; PG8_SCHED;
            PG8_LDB(B0, 1, 0); PG8_LDB(B1, 1, 1); PG8_SCHED; PG8_LDA(At, 1, 0); PG8_STAGE(PG8_SA(0, 1), a2 + hstepA, voffA);
            PG8_WAIT_V(8); PG8_WAIT_L(0); PG8_BAR; PG8_MMA(0, 0, At, B0); PG8_MMA(0, 1, At, B1); PG8_BAR; PG8_SCHED;
            PG8_LDA(At, 1, 1); PG8_STAGE(PG8_SB(1, 0), b3, voffB); PG8_STAGE(PG8_SB(1, 1), b3 + hstepB, voffB); PG8_STAGE(PG8_SA(1, 0), a3, voffA);
            PG8_WAIT_V(8); PG8_WAIT_L(0); PG8_BAR; PG8_MMA(1, 0, At, B0); PG8_MMA(1, 1, At, B1); PG8_BAR; PG8_SCHED;
        }
        if (wr == 0) PG8_BAR;
        {
            const int rbase = cur.pm * BM + wr * 64 + fr, cbase = cur.pn * BM + wc * 32 + 8 * fq;
#pragma unroll
            for (int ai = 0; ai < 2; ++ai)
#pragma unroll
                for (int m = 0; m < 4; ++m)
#pragma unroll
                    for (int bj = 0; bj < 2; ++bj) E.elem(rbase + ai * HALF + m * 16, cbase + bj * HALF, acc[ai][bj][m][0], acc[ai][bj][m][1]);
        }
        if (!has_next) break;
#pragma unroll
        for (int a = 0; a < 2; ++a)
#pragma unroll
            for (int b = 0; b < 2; ++b)
#pragma unroll
                for (int m = 0; m < 4; ++m)
#pragma unroll
                    for (int n = 0; n < 2; ++n) acc[a][b][m][n] = (f32x4){0.f, 0.f, 0.f, 0.f};
        cur = nxt; cA = nA; cB = nB; ++ui;
        if (wr == 1) PG8_BAR;
    }
    PG8_WAIT_V(0);
    PG8_BAR;
#undef PG8_SA
#undef PG8_SB
#undef PG8_STAGE
#undef PG8_LDA
#undef PG8_LDB
#undef PG8_MMA
#undef PG8_WAIT_V
#undef PG8_WAIT_L
#undef PG8_BAR
#undef PG8_SCHED
}
struct CacheGemm { const float* cache; const int* pt; const bf16_t* Bt; int kind; };
template <class Epi>
__device__ __forceinline__ void gemm_phase_cache(LAS unsigned char* lds, const CacheGemm g, const StaticOrder& S, const Epi& E) {
    const int tid = threadIdx.x, wid = __builtin_amdgcn_readfirstlane(tid >> 6), lane = tid & 63, wr = wid >> 2, wc = wid & 3, fr = lane & 15, fq = lane >> 4;
    constexpr int K = 1024;
    unsigned voffB[2];
#pragma unroll
    for (int i = 0; i < 2; ++i) { int R, C; stage_rc(tid * 16 + i * 8192, R, C); const int Rb = (R & ~31) + perm32(R & 31); voffB[i] = (unsigned)(Rb * K + C) * 2u; }
    const size_t kstepB = (size_t)(BK * 2), hstepB = (size_t)HALF * K * 2, tstepB = 2 * hstepB;
    const unsigned ldsw = (unsigned)wid * 1024u;
    const int aoff = lds_byte(wr * 64 + fr, fq * 8), boff = lds_byte(wc * 32 + fr, fq * 8);
    const unsigned laneoff = (unsigned)((lane >> 5) * 32768 + (lane & 31) * 16);
    const unsigned lo0 = laneoff, lo1 = laneoff + 65536u, lo2 = laneoff + 131072u, lo3 = laneoff + 196608u;
    const int awoff = lds_byte(((lane >> 4) & 1) * 64 + wid * 8 + (lane >> 5), 4 * (lane & 15));
    const char* cacheb = (const char*)g.cache;
#define PG8_STAGEB(sbo_, h, gbase) do { _Pragma("unroll") for (int _i = 0; _i < 2; ++_i) \
        __builtin_amdgcn_global_load_lds((const unsigned*)((const char*)(gbase) + voffB[_i]), (LAS unsigned*)(lds + (sbo_) + (h) * HTB + ldsw + _i * 8192), 16, 0, 0); } while (0)
#define PG8_LDR(dst, ub, tile) do { const char* sb_ = cacheb + (ub) + (size_t)((tile) * 2048); \
        asm volatile("global_load_dwordx4 %0, %1, %2" : "=v"(dst[0]) : "v"(lo0), "s"(sb_) : "memory"); asm volatile("global_load_dwordx4 %0, %1, %2" : "=v"(dst[1]) : "v"(lo1), "s"(sb_) : "memory"); \
        asm volatile("global_load_dwordx4 %0, %1, %2" : "=v"(dst[2]) : "v"(lo2), "s"(sb_) : "memory"); asm volatile("global_load_dwordx4 %0, %1, %2" : "=v"(dst[3]) : "v"(lo3), "s"(sb_) : "memory"); } while (0)
#define PG8_CVW(src, b) do { asm volatile("" : "+v"(src[0]), "+v"(src[1]), "+v"(src[2]), "+v"(src[3])); _Pragma("unroll") for (int _i = 0; _i < 4; ++_i) { u32x2 w_; w_.x = pk2(src[_i].x, src[_i].y); w_.y = pk2(src[_i].z, src[_i].w); *(LAS u32x2*)(lds + (b) * HTB + awoff + _i * 128) = w_; } } while (0)
#define PG8_LDA(dst, b, h) do { _Pragma("unroll") for (int m = 0; m < 4; ++m) dst[m] = *(const LAS bf16x8*)(lds + (b) * HTB + aoff + m * 2048 + (h) * 1024); } while (0)
#define PG8_LDB(dst, sbo_, h) do { _Pragma("unroll") for (int n = 0; n < 2; ++n) _Pragma("unroll") for (int k = 0; k < 2; ++k) dst[n][k] = *(const LAS bf16x8*)(lds + (sbo_) + (h) * HTB + boff + n * 2048 + k * 1024); } while (0)
#define PG8_MMAK(kk, bj, At, Bt) do { __builtin_amdgcn_s_setprio(1); _Pragma("unroll") for (int m = 0; m < 4; ++m) _Pragma("unroll") for (int n = 0; n < 2; ++n) \
        acc[bj][m][n] = __builtin_amdgcn_mfma_f32_16x16x32_bf16(Bt[n][kk], At[m], acc[bj][m][n], 0, 0, 0); __builtin_amdgcn_s_setprio(0); } while (0)
#define PG8_WAIT_V(n) asm volatile("s_waitcnt vmcnt(" #n ")" ::: "memory")
#define PG8_WAIT_L(n) asm volatile("s_waitcnt lgkmcnt(" #n ")" ::: "memory")
#define PG8_MEMB asm volatile("" ::: "memory")
#define PG8_BAR __builtin_amdgcn_s_barrier()
#define PG8_SCHED __builtin_amdgcn_sched_barrier(0)
#define PG8_UBASE(u) ((size_t)__builtin_amdgcn_readfirstlane((int)ptl[((u).pm >> 4) * NPAGES + 8 * ((u).pm & 15) + wid]) * (size_t)(PAGE * 2048) + (size_t)(((u).pn >> 1) * 512))
#define PG8_BBASE(u) ((const char*)g.Bt + (size_t)((u).pn >> 1) * 2 * tstepB + (size_t)((u).pn & 1) * hstepB)
    LAS unsigned short* ptl = (LAS unsigned short*)(lds + STAGE_BYTES);
    for (int i = tid; i < NSMP * NPAGES; i += 512) ptl[i] = (unsigned short)g.pt[i];
    asm volatile("s_waitcnt vmcnt(0) lgkmcnt(0)" ::: "memory"); PG8_BAR;
    Unit cur, nxt; int ui = 0;
    if (!S.next(0, cur)) return;
    f32x4 acc[2][4][2];
#pragma unroll
    for (int b = 0; b < 2; ++b)
#pragma unroll
        for (int m = 0; m < 4; ++m)
#pragma unroll
            for (int n = 0; n < 2; ++n) acc[b][m][n] = (f32x4){0.f, 0.f, 0.f, 0.f};
    bf16x8 At[4], B0[2][2], B1[2][2];
    f32x4 R0[4], R1[4], R2[4], R3[4];
    size_t uA = PG8_UBASE(cur), uN = uA;
    const char* cB = PG8_BBASE(cur);
    int sbo = 2 * HTB;
    PG8_LDR(R0, uA, 0); PG8_MEMB;
    PG8_STAGEB(2 * HTB, 0, cB); PG8_STAGEB(2 * HTB, 1, cB + tstepB);
    PG8_STAGEB(4 * HTB, 0, cB + kstepB); PG8_STAGEB(4 * HTB, 1, cB + tstepB + kstepB);
    PG8_STAGEB(6 * HTB, 0, cB + 2 * kstepB); PG8_STAGEB(6 * HTB, 1, cB + tstepB + 2 * kstepB); PG8_MEMB;
    PG8_LDR(R1, uA, 1); PG8_LDR(R2, uA, 2); PG8_LDR(R3, uA, 3); PG8_MEMB;
    PG8_WAIT_V(24); PG8_CVW(R0, 0); PG8_MEMB;
    PG8_LDR(R0, uA, 4); PG8_MEMB;
    PG8_WAIT_V(8); PG8_WAIT_L(0);
    if (wr == 1) PG8_BAR;
    PG8_BAR;
#define PG8_KT(j, RN) do { const int t_ = 4 * it + (j); \
        PG8_LDB(B0, sbo, 0); PG8_LDB(B1, sbo, 1); PG8_SCHED; PG8_LDA(At, (j) & 1, 0); \
        PG8_WAIT_L(0); PG8_BAR; PG8_MMAK(0, 0, At, B0); PG8_MMAK(0, 1, At, B1); PG8_BAR; PG8_SCHED; \
        PG8_LDA(At, (j) & 1, 1); \
        { const int tb_ = t_ + 3; const bool nb_ = tb_ >= 16; const char* bs_ = (nb_ ? nB : cB) + (size_t)(nb_ ? tb_ - 16 : tb_) * kstepB; PG8_STAGEB(sbo, 0, bs_); PG8_STAGEB(sbo, 1, bs_ + tstepB); } \
        PG8_MEMB; PG8_SCHED; \
        PG8_CVW(RN, ((j) + 1) & 1); \
        { const int ta_ = t_ + 5; const bool na_ = ta_ >= 16; const size_t ub_ = na_ ? uN : uA; const int tl_ = na_ ? ta_ - 16 : ta_; PG8_LDR(RN, ub_, tl_); } \
        PG8_MEMB; \
        PG8_WAIT_V(20); PG8_WAIT_L(0); PG8_BAR; PG8_MMAK(1, 0, At, B0); PG8_MMAK(1, 1, At, B1); PG8_BAR; PG8_SCHED; \
        sbo = sbo == 6 * HTB ? 2 * HTB : sbo + 2 * HTB; } while (0)
    for (;;) {
        const bool has_next = S.next(ui + 1, nxt);
        uN = has_next ? PG8_UBASE(nxt) : uA;
        const char* nB = has_next ? PG8_BBASE(nxt) : cB;
#pragma nounroll
        for (int it = 0; it < 4; ++it) { PG8_KT(0, R1); PG8_KT(1, R2); PG8_KT(2, R3); PG8_KT(3, R0); }
        if (wr == 0) PG8_BAR;
        {
            const int rbase0 = ((cur.pm >> 4) * 2 + wr) * 1024 + 64 * (cur.pm & 15), cb0 = (cur.pn & 1) * HALF + wc * 32 + 8 * fq;
            E.unit(acc, cur.pn >> 1, rbase0, cb0, fr, lane);
        }
        if (!has_next) break;
#pragma unroll
        for (int b = 0; b < 2; ++b)
#pragma unroll
            for (int m = 0; m < 4; ++m)
#pragma unroll
                for (int n = 0; n < 2; ++n) acc[b][m][n] = (f32x4){0.f, 0.f, 0.f, 0.f};
        cur = nxt; cB = nB; uA = uN; ++ui;
        if (wr == 1) PG8_BAR;
    }
    PG8_WAIT_V(0);
    asm volatile("" :: "v"(R0[0]), "v"(R0[1]), "v"(R0[2]), "v"(R0[3]), "v"(R1[0]), "v"(R1[1]), "v"(R1[2]), "v"(R1[3]));
    asm volatile("" :: "v"(R2[0]), "v"(R2[1]), "v"(R2[2]), "v"(R2[3]), "v"(R3[0]), "v"(R3[1]), "v"(R3[2]), "v"(R3[3]));
    PG8_SCHED;
    PG8_BAR;
#undef PG8_STAGEB
#undef PG8_LDR
#undef PG8_CVW
#undef PG8_LDA
#undef PG8_LDB
#undef PG8_MMAK
#undef PG8_UBASE
#undef PG8_BBASE
#undef PG8_KT
#undef PG8_MEMB
#undef PG8_WAIT_V
#undef PG8_WAIT_L
#undef PG8_BAR
#undef PG8_SCHED
}
}
#define XB_TMO      128
#define XB_XCNT(j)  (256  + 64 * (j))
#define XB_XSUB(j)  (1280 + 64 * (j))
#define XB_XGEN(j)  (2304 + 64 * (j))
#define XB_TOP      3328
#define XB_TOPGEN   3392
#define XCD_BAR_WORDS 3456
#define XB_SPIN_CAP (1u << 18)

__device__ __forceinline__ unsigned xb_ld(unsigned* p)              { return __hip_atomic_load(p, __ATOMIC_RELAXED, __HIP_MEMORY_SCOPE_AGENT); }
__device__ __forceinline__ unsigned xb_add(unsigned* p, unsigned v) { return __hip_atomic_fetch_add(p, v, __ATOMIC_RELAXED, __HIP_MEMORY_SCOPE_AGENT); }
__device__ __forceinline__ unsigned xb_xcc_id() { return (unsigned)__builtin_amdgcn_s_getreg((3 << 11) | 20) & 0xFu; }
#define XB_SPIN(cond, bar) do { unsigned _sp = 0; while (cond) { __builtin_amdgcn_s_sleep(1); \
    if ((++_sp & 255u) == 0u) { if (xb_ld(&(bar)[XB_TMO])) break; if (_sp > XB_SPIN_CAP) { atomicAdd(&(bar)[XB_TMO], 1u); break; } } } } while (0)

struct XcdBarrier {
    unsigned* bar; unsigned x;
    volatile LAS unsigned* st;
};

__device__ __forceinline__ XcdBarrier xcd_barrier_post(unsigned* bar, volatile LAS unsigned* st) {
    XcdBarrier b; b.bar = bar; b.x = xb_xcc_id(); b.st = st;
    if (threadIdx.x == 0) (void)xb_add(&bar[XB_XCNT(b.x)], 1u);
    return b;
}
__device__ __forceinline__ void xcd_barrier_complete(unsigned* bar, unsigned x, unsigned& nloc, unsigned& nx) {
    const unsigned G = gridDim.x * gridDim.y * gridDim.z;
    unsigned sum, cnt, mine, sp = 0u;
    for (;;) {
        sum = 0u; cnt = 0u; mine = 0u;
#pragma unroll
        for (unsigned j = 0; j < 16; ++j) { const unsigned c = xb_ld(&bar[XB_XCNT(j)]); sum += c; cnt += (c > 0u) ? 1u : 0u; mine = (j == x) ? c : mine; }
        if (sum == G) break;
        __builtin_amdgcn_s_sleep(1);
        if ((++sp & 255u) == 0u) { if (xb_ld(&bar[XB_TMO])) break; if (sp > XB_SPIN_CAP) { atomicAdd(&bar[XB_TMO], 1u); break; } }
    }
    nloc = mine > 0u ? mine : 1u; nx = cnt > 0u ? cnt : 1u;
}

__device__ __forceinline__ void xcd_barrier(const XcdBarrier& b) {
    asm volatile("s_waitcnt vmcnt(0)" ::: "memory");
    __syncthreads();
    if (threadIdx.x == 0) {
        unsigned* bar = b.bar;
        __builtin_amdgcn_s_waitcnt(0);
        unsigned nloc = b.st[0], nx = b.st[1];
        if (nloc == 0u) { xcd_barrier_complete(bar, b.x, nloc, nx); b.st[0] = nloc; b.st[1] = nx; }
        const unsigned old = xb_add(&bar[XB_XSUB(b.x)], 1u);
        const unsigned gen = old / nloc;
        if (old + 1u == (gen + 1u) * nloc) {
            __builtin_amdgcn_fence(__ATOMIC_RELEASE, "agent");
            asm volatile("s_waitcnt vmcnt(0)" ::: "memory");
            const unsigned og = xb_add(&bar[XB_TOP], 1u);
            const unsigned tg = og / nx;
            if (og + 1u == (tg + 1u) * nx) xb_add(&bar[XB_TOPGEN], 1u);
            else XB_SPIN(xb_ld(&bar[XB_TOPGEN]) == tg, bar);
            __builtin_amdgcn_fence(__ATOMIC_ACQUIRE, "agent");
            xb_add(&bar[XB_XGEN(b.x)], 1u);
            asm volatile("s_waitcnt vmcnt(0)" ::: "memory");
        } else {
            XB_SPIN(xb_ld(&bar[XB_XGEN(b.x)]) == gen, bar);
            __builtin_amdgcn_fence(__ATOMIC_ACQUIRE, "agent");
            asm volatile("s_waitcnt vmcnt(0)" ::: "memory");
        }
    }
    __syncthreads();
}
__device__ __forceinline__ void xcd_flag_arrive(const XcdBarrier& b, unsigned* F) {
    asm volatile("s_waitcnt vmcnt(0)" ::: "memory");
    __syncthreads();
    if (threadIdx.x == 0) {
        __builtin_amdgcn_s_waitcnt(0);
        const unsigned nloc = b.st[0];
        const unsigned old = xb_add(&F[XB_XSUB(b.x)], 1u);
        if (old + 1u == nloc) { __builtin_amdgcn_fence(__ATOMIC_RELEASE, "agent"); asm volatile("s_waitcnt vmcnt(0)" ::: "memory"); xb_add(&F[XB_TOP], 1u); }
    }
}
__device__ __forceinline__ void xcd_flag_wait(const XcdBarrier& b, unsigned* F) {
    if (threadIdx.x == 0) {
        const unsigned nx = b.st[1];
        XB_SPIN(xb_ld(&F[XB_TOP]) < nx, b.bar);
        __builtin_amdgcn_fence(__ATOMIC_ACQUIRE, "agent");
        asm volatile("s_waitcnt vmcnt(0)" ::: "memory");
    }
    __syncthreads();
}
constexpr int NWAVES = 8;
constexpr int RING_BYTES = 139264, MISC_OFF = RING_BYTES + 320, LDS_BYTES = 147456;
enum { I_XP = 0, I_XS, I_CP, I_CS, I_CKV, I_CWIN, I_SC, I_SN, I_SM, I_PT, I_RB, I_WADA, I_BADA, I_GMIX, I_GFFN, I_WIN, I_GATEB, I_PE, I_W1, I_W2, I_GNORM, I_WBA, I_WBB, I_WOUT, I_WFI, I_WFO, I_WADAF, I_BADAF, I_GFIN, N_INPUTS };
struct Args { const void* in[N_INPUTS]; float* out; unsigned char* ws; int ph_lo, ph_hi; };
static_assert(sizeof(Args) == 256, "Args has no padding");
#define LDS_WAIT() asm volatile("s_waitcnt lgkmcnt(0)" ::: "memory")
#define VM_WAIT() asm volatile("s_waitcnt vmcnt(0)" ::: "memory")
#define INF(a, k) ((const float*)(a).in[k])

struct MapId { DI int operator()(int n) const { return n; } };
struct MapZ {
    DI int operator()(int n) const {
        if (n < 1280) return n;
        if (n < 1304) return 5376 + (n - 1280);
        if (n < 2840) return 1280 + (n - 1304);
        if (n < 2848) return 5400 + (n - 2840);
        if (n < 3360) return 2816 + (n - 2848);
        return 3328 + (n - 3360);
    }
};
struct MapFFI { DI int operator()(int n) const { return n < FFH ? 8 * (n >> 2) + (n & 3) : 8 * ((n - FFH) >> 2) + 4 + ((n - FFH) & 3); } };
template <class Map>
DI void transpose_item(const float* W, int N, bf16_t* WT, int ldt, int koff, LAS float* scr, int item, int lane, Map map) {
    const int nblk = N / 32, kb = item / nblk, nb = item % nblk, k0 = 64 * kb, n0 = 32 * nb;
    float tv[32];
#pragma unroll
    for (int i = 0; i < 32; ++i) tv[i] = W[(size_t)(k0 + 2 * i + (lane >> 5)) * N + n0 + (lane & 31)];
#pragma unroll
    for (int i = 0; i < 32; ++i) scr[(2 * i + (lane >> 5)) * 33 + (lane & 31)] = tv[i];
    LDS_WAIT(); asm volatile("" ::: "memory");
    const int c = lane & 7;
#pragma unroll
    for (int j = 0; j < 4; ++j) { const int n = (lane >> 3) + 8 * j; const LAS float* s = scr + (8 * c) * 33 + n;
        u32x4 o; o.x = pk2(s[0 * 33], s[1 * 33]); o.y = pk2(s[2 * 33], s[3 * 33]); o.z = pk2(s[4 * 33], s[5 * 33]); o.w = pk2(s[6 * 33], s[7 * 33]);
        *(u32x4*)(WT + (size_t)map(n0 + n) * ldt + koff + k0 + 8 * c) = o; }
    LDS_WAIT(); asm volatile("" ::: "memory");
}
DI bf16x8 pack8(f32x4 a, f32x4 b) { u32x4 p; p.x = pk2(a.x, a.y); p.y = pk2(a.z, a.w); p.z = pk2(b.x, b.y); p.w = pk2(b.z, b.w); return __builtin_bit_cast(bf16x8, p); }
DI void mod_task(const float* W, const float* bias, int N, int col0, const float* cp, const float* cs, float* out, LAS unsigned char* lds, int wave, int lane) {
    const int fr = lane & 15, fq = lane >> 4;
    f32x4 acc[3][2];
#pragma unroll
    for (int i = 0; i < 3; ++i) { acc[i][0] = (f32x4){0.f, 0.f, 0.f, 0.f}; acc[i][1] = acc[i][0]; }
    const float* arow[3];
#pragma unroll
    for (int i = 0; i < 3; ++i) { int r = 16 * i + fr; r = r < 40 ? r : 39; arow[i] = (r < 8 ? cp + (size_t)r * D : cs + (size_t)(r - 8) * D) + 8 * fq + 128 * wave; }
#pragma unroll
    for (int k0 = 0; k0 < 128; k0 += 32) {
        bf16x8 bfr[2];
#pragma unroll
        for (int n = 0; n < 2; ++n) { const float* wp = W + (size_t)(128 * wave + k0 + 8 * fq) * N + col0 + 16 * n + fr;
            float w[8];
#pragma unroll
            for (int j = 0; j < 8; ++j) w[j] = wp[(size_t)j * N];
            u32x4 p; p.x = pk2(w[0], w[1]); p.y = pk2(w[2], w[3]); p.z = pk2(w[4], w[5]); p.w = pk2(w[6], w[7]); bfr[n] = __builtin_bit_cast(bf16x8, p); }
#pragma unroll
        for (int i = 0; i < 3; ++i) { const f32x4 a0 = *(const f32x4*)(arow[i] + k0), a1 = *(const f32x4*)(arow[i] + k0 + 4); const bf16x8 af = pack8(a0, a1);
#pragma unroll
            for (int n = 0; n < 2; ++n) acc[i][n] = __builtin_amdgcn_mfma_f32_16x16x32_bf16(af, bfr[n], acc[i][n], 0, 0, 0); }
    }
    LAS float* P = (LAS float*)lds;
#pragma unroll
    for (int i = 0; i < 3; ++i)
#pragma unroll
        for (int n = 0; n < 2; ++n)
#pragma unroll
            for (int j = 0; j < 4; ++j) P[(wave * 48 + 16 * i + 4 * fq + j) * 32 + 16 * n + fr] = acc[i][n][j];
    __syncthreads();
    for (int o = wave * 64 + lane; o < 40 * 32; o += 512) { const int r = o >> 5, c = o & 31; float t = bias[col0 + c];
#pragma unroll
        for (int w = 0; w < 8; ++w) t += P[(w * 48 + r) * 32 + c];
        out[(size_t)r * N + col0 + c] = t; }
    __syncthreads();
}
DI void conv_range(const Args& a, int it0, int it_end, int step, int lane) {
    unsigned char* ws = a.ws;
    const float* ckv = INF(a, I_CKV); const int* pt = (const int*)a.in[I_PT];
    const int pr = lane >> 5, c8 = lane & 31, seg = c8 >> 3, kind = seg >> 1, g = seg & 1, d = (c8 & 7) * 8;
    bf16_t* dbase = (bf16_t*)(ws + WS_ABF + (size_t)kind * ABF_KIND) + (size_t)AROWS_P * 1024 + d;
    for (int it = it0; it < it_end; it += 2 * step) {
        f32x4 v[2][4][2]; bf16_t* dst[2];
#pragma unroll
        for (int u = 0; u < 2; ++u) { const int itu = it + u * step; const int itc = itu < it_end ? itu : it;
            const int s = itc >> 11, rem = itc & 2047, p = rem >> 4, slot0 = (rem & 15) * 8 + pr;
            const int page = pt[s * NPAGES + p];
            const float* src = ckv + ((size_t)page * PAGE + slot0) * 512 + c8 * 8;
            dst[u] = dbase + ((size_t)(s * 2 + g) * 1024) * 1024 + (size_t)(p * PAGE + slot0) * 64;
#pragma unroll
            for (int i = 0; i < 4; ++i) { v[u][i][0] = __builtin_nontemporal_load((const f32x4*)(src + i * 1024)); v[u][i][1] = __builtin_nontemporal_load((const f32x4*)(src + i * 1024 + 4)); } }
#pragma unroll
        for (int u = 0; u < 2; ++u)
#pragma unroll
            for (int i = 0; i < 4; ++i) { u32x4 o; o.x = pk2(v[u][i][0].x, v[u][i][0].y); o.y = pk2(v[u][i][0].z, v[u][i][0].w); o.z = pk2(v[u][i][1].x, v[u][i][1].y); o.w = pk2(v[u][i][1].z, v[u][i][1].w); *(u32x4*)(dst[u] + i * 128) = o; }
    }
}
#ifndef PRETOUCH
#define PRETOUCH 0
#endif
DI void touch_region(const void* base, size_t bytes, int gt, int NGT) {
    const char* p = (const char*)base; unsigned acc = 0u;
    for (size_t o = (size_t)gt * 65536; o < bytes; o += (size_t)NGT * 65536) acc += __builtin_nontemporal_load((const unsigned*)(p + o));
    asm volatile("" :: "v"(acc));
}
DI void p0_prologue(const Args& a, LAS unsigned char* lds, int gw, int NGW, int wave, int lane) {
    unsigned char* ws = a.ws;
    if (PRETOUCH) { const int gt = gw * 64 + lane, NGT = NGW * 64;
        touch_region(ws, WS_END, gt, NGT); touch_region(a.in[I_CKV], (size_t)5120 * 128 * 512 * 4, gt, NGT); touch_region(a.in[I_XP], (size_t)MPR * D * 4, gt, NGT); touch_region(a.out, O_END * 4, gt, NGT);
        touch_region(a.in[I_WADA], (size_t)1024 * 6144 * 4, gt, NGT); touch_region(a.in[I_WIN], (size_t)1024 * NIN * 4, gt, NGT); touch_region(a.in[I_WFI], (size_t)1024 * NFF * 4, gt, NGT); touch_region(a.in[I_WFO], (size_t)FFH * 1024 * 4, gt, NGT);
        touch_region(a.in[I_CWIN], (size_t)NSMP * 512 * 256 * 4, gt, NGT); touch_region(a.in[I_SC], (size_t)NSMP * 4 * 16384 * 4, gt, NGT); }
    for (int task = gw >> 3; task < 256; task += NGW >> 3) {
        if (task < 192) mod_task(INF(a, I_WADA), INF(a, I_BADA), 6144, task * 32, INF(a, I_CP), INF(a, I_CS), (float*)(ws + WS_MOD), lds, wave, lane);
        else mod_task(INF(a, I_WADAF), INF(a, I_BADAF), 2048, (task - 192) * 32, INF(a, I_CP), INF(a, I_CS), (float*)(ws + WS_MODF), lds, wave, lane);
    }
    {
        LAS float* scr = (LAS float*)(lds + wave * 16384);
        constexpr int I_A = 16 * 169;
        for (int it = gw; it < I_A; it += NGW) transpose_item(INF(a, I_WIN), NIN, (bf16_t*)(ws + WS_WIN_T), 1024, 0, scr, it, lane, MapZ());
    }
}
DI void cbias_task(const Args& a, LAS unsigned char* lds, int task, int wave, int lane) {
    unsigned char* ws = a.ws;
    const int kind = task >> 2, f = (task & 3) * 64 + lane; const float* pe = INF(a, I_PE) + kind * 2048 + wave * 256; const float* w1 = INF(a, I_W1) + ((size_t)kind * 2048 + wave * 256) * 256 + f;
    float sacc[4] = {0.f, 0.f, 0.f, 0.f};
#pragma unroll 8
    for (int k = 0; k < 256; k += 4) {
#pragma unroll
        for (int j = 0; j < 4; ++j) sacc[j] += pe[k + j] * w1[(size_t)(k + j) * 256]; }
    LAS float* red = (LAS float*)lds;
    __syncthreads();
    red[wave * 64 + lane] = (sacc[0] + sacc[1]) + (sacc[2] + sacc[3]);
    __syncthreads();
    if (wave == 0) { float t = 0.f;
#pragma unroll
        for (int w = 0; w < 8; ++w) t += red[w * 64 + lane];
        ((float*)(ws + WS_CBIAS))[kind * 256 + f] = t; }
    __syncthreads();
}
template <int PART> DI void late_transposes(const Args& a, LAS unsigned char* lds, int widx, int nw, int wave, int lane) {
    unsigned char* ws = a.ws;
    LAS float* scr = (LAS float*)(lds + wave * 16384);
    constexpr int I_B = 8 * 32, I_C = 8 * 32, I_D = 16 * 32, I_E = 16 * 176, I_F = 44 * 32, I_G = 32 * 8, I_H = 4 * 2;
    constexpr int NITEMS = PART == 0 ? 2 * I_G + 2 * I_H + I_B + I_C + I_D + I_E : (PART == 2 ? 2 * I_G : I_F);
    for (int it = widx; it < NITEMS; it += nw) {
        int r = it;
        if (PART == 1) { transpose_item(INF(a, I_WFO), 1024, (bf16_t*)(ws + WS_WFO_T), FFH, 0, scr, r, lane, MapId()); continue; }
        if (PART == 0) { if (r < 2 * I_G) { const int kind = r / I_G; transpose_item(INF(a, I_W1) + (size_t)kind * 2048 * 256, 256, (bf16_t*)(ws + WS_W1C_T) + (size_t)kind * 256 * 2048, 2048, 0, scr, r % I_G, lane, MapId()); continue; } r -= 2 * I_G; }
        if (PART == 2) { const int kind = r / I_G, it2 = r % I_G, upper = (it2 / 8) >= 16;
            transpose_item(INF(a, I_W1) + (size_t)kind * 2048 * 256, 256, (bf16_t*)(ws + WS_W1P_T) + (size_t)kind * 512 * 1024 + (upper ? 256 * 1024 : 0), 1024, upper ? -1024 : 0, scr, it2, lane, MapId()); continue; }
        if (r < 2 * I_H) { const int kind = r / I_H; transpose_item(INF(a, I_W2) + (size_t)kind * 256 * 64, 64, (bf16_t*)(ws + WS_W2C_T) + (size_t)kind * 64 * 256, 256, 0, scr, r % I_H, lane, MapId()); continue; } r -= 2 * I_H;
        if (r < I_B) { transpose_item(INF(a, I_WBA), 1024, (bf16_t*)(ws + WS_WBR_T), 1024, 0, scr, r, lane, MapId()); continue; } r -= I_B;
        if (r < I_C) { transpose_item(INF(a, I_WBB), 1024, (bf16_t*)(ws + WS_WBR_T), 1024, 512, scr, r, lane, MapId()); continue; } r -= I_C;
        if (r < I_D) { transpose_item(INF(a, I_WOUT), 1024, (bf16_t*)(ws + WS_WOUT_T), 1024, 0, scr, r, lane, MapId()); continue; } r -= I_D;
        if (r < I_E) { transpose_item(INF(a, I_WFI), NFF, (bf16_t*)(ws + WS_WFI_T), 1024, 0, scr, r, lane, MapFFI()); continue; } r -= I_E;
        transpose_item(INF(a, I_WFO), 1024, (bf16_t*)(ws + WS_WFO_T), FFH, 0, scr, r, lane, MapId());
    }
}
DI void win_copy(const Args& a, int widx, int nw, int lane) {
    const float* cw = INF(a, I_CWIN); float* ow = a.out + O_WINS;
    for (int it0 = widx * 4; it0 < NSMP * 511; it0 += nw * 4) { f32x4 v[4];
#pragma unroll
        for (int u = 0; u < 4; ++u) { const int it = it0 + u < NSMP * 511 ? it0 + u : it0; const int s = it / 511, w = it % 511; v[u] = *(const f32x4*)(cw + ((size_t)s * 512 + w + 1) * 256 + lane * 4); }
#pragma unroll
        for (int u = 0; u < 4; ++u) { const int it = it0 + u < NSMP * 511 ? it0 + u : it0; const int s = it / 511, w = it % 511; *(f32x4*)(ow + ((size_t)s * 512 + w) * 256 + lane * 4) = v[u]; }
    }
}
template <bool BF> DI void norm_load(const void* xrv, int lane, f32x4 (&v)[4]) {
#pragma unroll
    for (int j = 0; j < 4; ++j) {
        if (BF) { const u32x2 w = *(const u32x2*)((const bf16_t*)xrv + 4 * lane + 256 * j); v[j] = (f32x4){bf2f(w.x & 0xffffu), bf2f(w.x >> 16), bf2f(w.y & 0xffffu), bf2f(w.y >> 16)}; }
        else v[j] = *(const f32x4*)((const float*)xrv + 4 * lane + 256 * j); }
}
DI void norm_finish(f32x4 (&v)[4], const float* g, const float* shift, const float* scale, int lane) {
    float s = 0.f;
#pragma unroll
    for (int j = 0; j < 4; ++j) s += (v[j].x * v[j].x + v[j].y * v[j].y) + (v[j].z * v[j].z + v[j].w * v[j].w);
    const float rstd = 1.f / sqrtf(wave_sum(s) * (1.f / D) + EPS);
#pragma unroll
    for (int j = 0; j < 4; ++j) { const int c = 4 * lane + 256 * j; const f32x4 gv = *(const f32x4*)(g + c), sh = *(const f32x4*)(shift + c), sc = *(const f32x4*)(scale + c);
        v[j] = (v[j] * rstd) * gv * (sc + 1.f) + sh; }
}
DI void norm_phase_bf16(const Args& a, int which, int gw, int NGW, int lane) {
    unsigned char* ws = a.ws; bf16_t* U = (bf16_t*)(ws + WS_U); const float* mod = (const float*)(ws + WS_MOD);
    const float* g = INF(a, which == 0 ? I_GMIX : I_GFFN);
    for (int row0 = gw; row0 < MP; row0 += 2 * NGW) {
        f32x4 v[2][4]; int rows[2]; rows[0] = row0; rows[1] = row0 + NGW;
#pragma unroll
        for (int u = 0; u < 2; ++u) { const int row = rows[u]; if (row < MREAL) {
            if (which == 0) norm_load<false>(row < MPR ? INF(a, I_XP) + (size_t)row * D : INF(a, I_XS) + (size_t)(row - MPR) * D, lane, v[u]);
            else norm_load<true>((const bf16_t*)(ws + WS_X1) + (size_t)row * D, lane, v[u]); } }
#pragma unroll
        for (int u = 0; u < 2; ++u) { const int row = rows[u]; if (row >= MP) continue;
            u32x2* o = (u32x2*)(U + (size_t)row * D) + lane;
            if (row >= MREAL) { for (int j = 0; j < 4; ++j) o[64 * j] = (u32x2){0u, 0u}; continue; }
            const int mrow = row < MPR ? (row >> 11) : 8 + (row - MPR);
            const float* mr = mod + (size_t)mrow * 6144 + (which == 0 ? 0 : 3 * 1024);
            norm_finish(v[u], g, mr, mr + 1024, lane);
#pragma unroll
            for (int j = 0; j < 4; ++j) { u32x2 w; w.x = pk2(v[u][j].x, v[u][j].y); w.y = pk2(v[u][j].z, v[u][j].w); o[64 * j] = w; } }
    }
}
DI void final_norm_phase(const Args& a, int gw, int NGW, int lane) {
    unsigned char* ws = a.ws; const float* modf = (const float*)(ws + WS_MODF); const float* g = INF(a, I_GFIN);
    for (int row0 = gw; row0 < MREAL; row0 += 2 * NGW) {
        f32x4 v[2][4]; int rows[2]; rows[0] = row0; rows[1] = row0 + NGW;
#pragma unroll
        for (int u = 0; u < 2; ++u) if (rows[u] < MREAL) norm_load<true>((const bf16_t*)(ws + WS_X2) + (size_t)rows[u] * D, lane, v[u]);
#pragma unroll
        for (int u = 0; u < 2; ++u) { const int row = rows[u]; if (row >= MREAL) continue;
            const int mrow = row < MPR ? (row >> 11) : 8 + (row - MPR);
            const float* mr = modf + (size_t)mrow * 2048;
            norm_finish(v[u], g, mr, mr + 1024, lane);
            float* o = (row < MPR ? a.out + O_Y + (size_t)row * D : a.out + O_YS + (size_t)(row - MPR) * D) + 4 * lane;
#pragma unroll
            for (int j = 0; j < 4; ++j) *(f32x4*)(o + 256 * j) = v[u][j]; }
    }
}
DI float gelu_tanh(float x) { const float x2 = x * x; const float ny = x * (x2 * (-0.044715f * 1.5957691216057308f * 1.4426950408889634f) - 1.5957691216057308f * 1.4426950408889634f);
    return x * __builtin_amdgcn_rcpf(1.f + __builtin_amdgcn_exp2f(ny)); }
DI int paoff(int row, int ch) { return row * 512 + ((ch ^ (row & 15)) << 4); }
DI void pcmp_unit(const Args& a, LAS unsigned char* lds, int kind, int seq, int quarter, int wave, int lane) {
    unsigned char* ws = a.ws;
    const int tid = wave * 64 + lane;
    const int fr = lane & 15, fq = lane >> 4;
    const int arow0 = seq * 128 + 32 * quarter;
    const bf16_t* Ab = (const bf16_t*)(ws + WS_ABF + (size_t)kind * ABF_KIND) + (size_t)arow0 * 1024;
    const bf16_t* B = (const bf16_t*)(ws + WS_W1C_T) + (size_t)kind * 256 * 2048 + (size_t)(32 * wave + fr) * 2048 + 8 * fq;
    f32x4 acc[2][2];
#pragma unroll
    for (int i = 0; i < 2; ++i) { acc[i][0] = (f32x4){0.f, 0.f, 0.f, 0.f}; acc[i][1] = acc[i][0]; }
    u32x4 areg[2];
#pragma unroll
    for (int i = 0; i < 2; ++i) { const int idx = tid + 512 * i, rw = idx >> 5, ch = idx & 31; areg[i] = *(const u32x4*)(Ab + (size_t)rw * 1024 + ch * 8); }
    __syncthreads();
#pragma unroll 1
    for (int kc = 0; kc < 8; ++kc) {
        LAS unsigned char* abuf = lds + 65536 + (kc & 1) * 32768;
#pragma unroll
        for (int i = 0; i < 2; ++i) { const int idx = tid + 512 * i, rw = idx >> 5, ch = idx & 31; *(LAS u32x4*)(abuf + paoff(rw, ch)) = areg[i]; }
        __syncthreads();
        if (kc + 1 < 8) {
#pragma unroll
            for (int i = 0; i < 2; ++i) { const int idx = tid + 512 * i, rw = idx >> 5, ch = idx & 31; areg[i] = *(const u32x4*)(Ab + (size_t)rw * 1024 + (kc + 1) * 256 + ch * 8); } }
        bf16x8 bfr[8][2];
#pragma unroll
        for (int ks = 0; ks < 8; ++ks)
#pragma unroll
            for (int nt = 0; nt < 2; ++nt) bfr[ks][nt] = *(const bf16x8*)(B + (size_t)nt * 16 * 2048 + kc * 256 + 32 * ks);
#pragma unroll
        for (int ks = 0; ks < 8; ++ks)
#pragma unroll
            for (int mt = 0; mt < 2; ++mt) { const bf16x8 af = *(const LAS bf16x8*)(abuf + paoff(16 * mt + fr, 4 * ks + fq));
#pragma unroll
                for (int nt = 0; nt < 2; ++nt) acc[mt][nt] = __builtin_amdgcn_mfma_f32_16x16x32_bf16(af, bfr[ks][nt], acc[mt][nt], 0, 0, 0); }
    }
    LAS bf16_t* G = (LAS bf16_t*)lds;
    const float* cb = (const float*)(ws + WS_CBIAS) + kind * 256;
    __syncthreads();
#pragma unroll
    for (int mt = 0; mt < 2; ++mt)
#pragma unroll
        for (int nt = 0; nt < 2; ++nt) { const int col = 32 * wave + 16 * nt + fr; const float bv = cb[col];
#pragma unroll
            for (int j = 0; j < 4; ++j) G[(16 * mt + 4 * fq + j) * 264 + col] = (bf16_t)(pk2(gelu_tanh(acc[mt][nt][j] + bv), 0.f) & 0xffffu); }
    __syncthreads();
    {
        const int mt = wave >> 2, nt = wave & 3; const bf16_t* w2 = (const bf16_t*)(ws + WS_W2C_T) + (size_t)kind * 64 * 256 + (size_t)fr * 256 + 8 * fq;
        bf16_t* kc = (bf16_t*)(ws + WS_KC) + ((size_t)kind * AROWS + arow0 + 16 * mt) * 64;
        f32x4 c = {0.f, 0.f, 0.f, 0.f};
#pragma unroll
        for (int ks = 0; ks < 8; ++ks) { const bf16x8 af = *(const LAS bf16x8*)(G + (16 * mt + fr) * 264 + 32 * ks + 8 * fq); const bf16x8 bfr = *(const bf16x8*)(w2 + (size_t)nt * 16 * 256 + 32 * ks);
            c = __builtin_amdgcn_mfma_f32_16x16x32_bf16(af, bfr, c, 0, 0, 0); }
#pragma unroll
        for (int j = 0; j < 4; ++j) kc[(size_t)(4 * fq + j) * 64 + nt * 16 + fr] = (bf16_t)(pk2(c[j], 0.f) & 0xffffu);
    }
    __syncthreads();
}
DI void scan_unit(const Args& a, int task, int lane) {
    unsigned char* ws = a.ws;
    const int b = task >> 2, h = task & 3; const float* ga = (const float*)(ws + WS_GA) + (size_t)(b * T + lane) * 32;
    float ipv[32], fpv[32];
#pragma unroll
    for (int c = 0; c < 32; ++c) { ipv[c] = ga[(size_t)c * 64 * 32 + 24 + h]; fpv[c] = ga[(size_t)c * 64 * 32 + 28 + h]; }
    float Bc = 0.f, pm = 0.f;
    float* AL = (float*)(ws + WS_ALPHA) + task * 2048; float* BE = (float*)(ws + WS_BETA) + task * 2048; float* MT = (float*)(ws + WS_MT) + task * 2048;
#pragma unroll
    for (int c = 0; c < 32; ++c) {
        const int t = 64 * c + lane; const float ip = ipv[c], fp = fpv[c];
        float lf = fminf(fp, 0.f) - log1pf(__expf(-fabsf(fp)));
#pragma unroll
        for (int o = 1; o < 64; o <<= 1) { const float u = __shfl_up(lf, o); if (lane >= o) lf += u; }
        const float Bt = Bc + lf, beta = ip - Bt;
        float mx = beta;
#pragma unroll
        for (int o = 1; o < 64; o <<= 1) { const float u = __shfl_up(mx, o); if (lane >= o) mx = fmaxf(mx, u); }
        mx = fmaxf(mx, pm);
        AL[t] = -mx; BE[t] = beta; MT[t] = Bt + mx;
        Bc = __shfl(Bt, 63); pm = __shfl(mx, 63);
        if (c == 31 && lane == 63) a.out[O_MP + task] = Bt + mx;
    }
}
constexpr int W2_LDS = 65536;
DI void st8bf_(bf16_t* p, f32x4 v0, f32x4 v1) { u32x4 w; w.x = pk2(v0.x, v0.y); w.y = pk2(v0.z, v0.w); w.z = pk2(v1.x, v1.y); w.w = pk2(v1.z, v1.w); *(u32x4*)p = w; }
DI int w2off(int n, int ch) { return n * 512 + ((ch ^ (n & 31)) << 4); }
DI void w2_load(const Args& a, int task, int lane, u32x4 (&x0)[8], u32x4 (&x1)[8]) {
    const int fr = lane & 15, fq = lane >> 4;
    const int kind = task / (AROWS_S / 16), pr0 = (task % (AROWS_S / 16)) * 16;
    const bf16_t* h0 = (const bf16_t*)(a.ws + WS_GH) + ((size_t)kind * AROWS_S + pr0 + fr) * 256 + 8 * fq;
    const bool bnd = (task & 3) == 3 && fr == 15;
    const int hb = ((pr0 + 16) >> 6) < 1023 ? ((pr0 + 16) >> 6) : 1023;
    const bf16_t* h1 = (const bf16_t*)(a.ws + WS_GH) + (size_t)2 * AROWS_S * 256 + ((size_t)kind * 1024 + hb) * 256 + 8 * fq;
#pragma unroll
    for (int ks = 0; ks < 8; ++ks) { x0[ks] = *(const u32x4*)(h0 + 32 * ks); x1[ks] = bnd ? *(const u32x4*)(h1 + 32 * ks) : (u32x4){0u, 0u, 0u, 0u}; }
}
DI void w2_compute(const Args& a, LAS unsigned char* lds, int task, int lane, const u32x4 (&x0)[8], const u32x4 (&x1)[8]) {
    unsigned char* ws = a.ws;
    const int fr = lane & 15, fq = lane >> 4;
    const int kind = task / (AROWS_S / 16), row0 = AROWS_P + (task % (AROWS_S / 16)) * 16;
    const float* cb = (const float*)(ws + WS_CBIAS) + kind * 256 + 8 * fq;
    bf16x8 af[8];
#pragma unroll
    for (int ks = 0; ks < 8; ++ks) { const f32x4 c0 = *(const f32x4*)(cb + 32 * ks), c1 = *(const f32x4*)(cb + 32 * ks + 4);
        f32x4 g0, g1;
        g0.x = gelu_tanh(bf2f(x0[ks].x & 0xffffu) + bf2f(x1[ks].x & 0xffffu) + c0.x); g0.y = gelu_tanh(bf2f(x0[ks].x >> 16) + bf2f(x1[ks].x >> 16) + c0.y);
        g0.z = gelu_tanh(bf2f(x0[ks].y & 0xffffu) + bf2f(x1[ks].y & 0xffffu) + c0.z); g0.w = gelu_tanh(bf2f(x0[ks].y >> 16) + bf2f(x1[ks].y >> 16) + c0.w);
        g1.x = gelu_tanh(bf2f(x0[ks].z & 0xffffu) + bf2f(x1[ks].z & 0xffffu) + c1.x); g1.y = gelu_tanh(bf2f(x0[ks].z >> 16) + bf2f(x1[ks].z >> 16) + c1.y);
        g1.z = gelu_tanh(bf2f(x0[ks].w & 0xffffu) + bf2f(x1[ks].w & 0xffffu) + c1.z); g1.w = gelu_tanh(bf2f(x0[ks].w >> 16) + bf2f(x1[ks].w >> 16) + c1.w);
        af[ks] = pack8(g0, g1); }
    const LAS unsigned char* wl = lds + W2_LDS + kind * 32768;
    f32x4 acc[4];
#pragma unroll
    for (int nt = 0; nt < 4; ++nt) { acc[nt] = (f32x4){0.f, 0.f, 0.f, 0.f};
#pragma unroll
        for (int ks = 0; ks < 8; ++ks) { const bf16x8 wfr = *(const LAS bf16x8*)(wl + w2off(16 * (fr >> 2) + 4 * nt + (fr & 3), 4 * ks + fq)); acc[nt] = __builtin_amdgcn_mfma_f32_16x16x32_bf16(wfr, af[ks], acc[nt], 0, 0, 0); } }
    bf16_t* kc = (bf16_t*)(ws + WS_KC) + ((size_t)kind * AROWS + row0 + fr) * 64 + 16 * fq;
    st8bf_(kc, acc[0], acc[1]); st8bf_(kc + 8, acc[2], acc[3]);
}
DI void w2_stage(const Args& a, LAS unsigned char* lds, int tid) {
    volatile LAS int* W2F = (volatile LAS int*)(lds + RING_BYTES + 192);
    if (__builtin_amdgcn_readfirstlane(*W2F) == 0) {
        const bf16_t* src = (const bf16_t*)(a.ws + WS_W2C_T);
        for (int i = tid; i < 2 * 64 * 32; i += 512) { const int kind = i >> 11, n = (i >> 5) & 63, ch = i & 31;
            *(LAS u32x4*)(lds + W2_LDS + kind * 32768 + w2off(n, ch)) = *(const u32x4*)(src + ((size_t)kind * 64 + n) * 256 + ch * 8); }
        __syncthreads();
        if (tid == 0) *W2F = 1;
    }
}
DI void w2_unit(const Args& a, LAS unsigned char* lds, int v, int wave, int lane) {
    const int tid = wave * 64 + lane;
    w2_stage(a, lds, tid);
    const int t0 = 32 * v + 4 * wave;
    u32x4 xa0[8], xa1[8], xb0[8], xb1[8];
    w2_load(a, t0, lane, xa0, xa1);
    w2_load(a, t0 + 1, lane, xb0, xb1);
    w2_compute(a, lds, t0, lane, xa0, xa1);
    w2_load(a, t0 + 2, lane, xa0, xa1);
    w2_compute(a, lds, t0 + 1, lane, xb0, xb1);
    w2_load(a, t0 + 3, lane, xb0, xb1);
    w2_compute(a, lds, t0 + 2, lane, xa0, xa1);
    w2_compute(a, lds, t0 + 3, lane, xb0, xb1);
}
DI void st8bf(bf16_t* p, f32x4 v0, f32x4 v1) { u32x4 w; w.x = pk2(v0.x, v0.y); w.y = pk2(v0.z, v0.w); w.z = pk2(v1.x, v1.y); w.w = pk2(v1.z, v1.w); *(u32x4*)p = w; }
DI f32x4 sig4(f32x4 v) { f32x4 o; o.x = sigmoidf_(v.x); o.y = sigmoidf_(v.y); o.z = sigmoidf_(v.z); o.w = sigmoidf_(v.w); return o; }
DI f32x4 ld4bf(const bf16_t* p) { const u32x2 w = *(const u32x2*)p; f32x4 o; o.x = bf2f(w.x & 0xffffu); o.y = bf2f(w.x >> 16); o.z = bf2f(w.y & 0xffffu); o.w = bf2f(w.y >> 16); return o; }
constexpr float KSCALE = 0.08838834764831845f;

struct EpiZ {
    static constexpr bool HAS_MID = false; static constexpr int MID_T = 0;
    bf16_t *QA, *KVB, *QB, *KB, *VB, *OB, *GM, *ABF; float* GA; float* out; const float* gate_b;
    DI void mid(f32x4 (&)[2][2][4][2], const pg8::Unit&, int, int, int, int) const {}
    DI void elem(int row, int col0, f32x4 v0, f32x4 v1) const {
        const int tile = col0 >> 8;
        if (tile < 2) { st8bf(QA + (size_t)row * 512 + col0, v0 * QSCALE, v1 * QSCALE); }
        else if (tile < 5) {
            const int kv = col0 - 512;
            if (kv < 256) {
                if (row < MPR) { const int kind = kv >> 7, g = (kv >> 6) & 1, d = kv & 63, b = row >> 11, t = row & 2047;
                    st8bf(ABF + (size_t)kind * (ABF_KIND / 2) + ((size_t)(b * 2 + g) * 128) * 1024 + (size_t)t * 64 + d, v0, v1); }
            } else st8bf(KVB + (size_t)row * 512 + (kv - 256), v0, v1);
            if (kv < 512) {
                if (row < MPR) { float* o = out + O_KVP + (size_t)row * 512 + kv; *(f32x4*)o = v0; *(f32x4*)(o + 4) = v1; }
                else if (row < MREAL) { float* o = out + O_KVS + (size_t)(row - MPR) * 512 + kv; *(f32x4*)o = v0; *(f32x4*)(o + 4) = v1; }
            } else {
                const int wc = kv - 512;
                if (row < MPR) { const int t = row & 2047; if (t >= 1536) { float* o = out + O_WINP + ((size_t)(row >> 11) * 512 + (t - 1536)) * 256 + wc; *(f32x4*)o = v0; *(f32x4*)(o + 4) = v1; } }
                else if (row < MREAL) { float* o = out + O_WINS + ((size_t)(row - MPR) * 512 + 511) * 256 + wc; *(f32x4*)o = v0; *(f32x4*)(o + 4) = v1; }
            }
        }
        else if (tile < 7) st8bf(QB + (size_t)row * 512 + (col0 - 1280), v0, v1);
        else if (tile < 9) st8bf(KB + (size_t)row * 512 + (col0 - 1792), v0 * KSCALE, v1 * KSCALE);
        else if (tile < 11) st8bf(VB + (size_t)row * 512 + (col0 - 2304), v0, v1);
        else if (tile < 13) st8bf(OB + (size_t)row * 512 + (col0 - 2816), sig4(v0), sig4(v1));
        else if (tile < 21) st8bf(GM + (size_t)row * 2048 + (col0 - 3328), sig4(v0), sig4(v1));
        else { const int c = col0 - 5376; float* o = GA + (size_t)row * 32 + c;
            if (c < 24) { *(f32x4*)o = sig4(v0); *(f32x4*)(o + 4) = sig4(v1); }
            else if (c < 32) { *(f32x4*)o = v0 + *(const f32x4*)gate_b; *(f32x4*)(o + 4) = v1 + *(const f32x4*)(gate_b + 4); } }
    }
};
struct EpiPiece {
    static constexpr bool HAS_MID = false; static constexpr int MID_T = 0;
    bf16_t* H;
    DI void mid(f32x4 (&)[2][2][4][2], const pg8::Unit&, int, int, int, int) const {}
    DI void elem(int row, int col0, f32x4 v0, f32x4 v1) const { st8bf(H + (size_t)row * 512 + col0, v0, v1); }
};
struct EpiHid {
    bf16_t* HID0; bf16_t* HB10;
    DI void unit(const f32x4 (&acc)[2][4][2], int kind, int rbase0, int cb0, int fr, int lane) const {
        bf16_t* HID = HID0 + (size_t)kind * AROWS_S * 256; bf16_t* HB1 = HB10 + (size_t)kind * 1024 * 256;
        const int src = ((lane & 48) | ((lane + 1) & 15)) << 2;
#pragma unroll
        for (int m = 0; m < 4; ++m) { f32x4 sv[2];
#pragma unroll
            for (int n = 0; n < 2; ++n)
#pragma unroll
                for (int j = 0; j < 4; ++j) { const float x = acc[1][m][n][j], xn = m < 3 ? acc[1][m + 1][n][j] : x; const float y = fr == 0 ? xn : x;
                    const float sh = __builtin_bit_cast(float, __builtin_amdgcn_ds_bpermute(src, __builtin_bit_cast(int, y)));
                    sv[n][j] = acc[0][m][n][j] + ((m == 3 && fr == 15) ? 0.f : sh); }
            st8bf(HID + (size_t)(rbase0 + m * 16 + fr) * 256 + cb0, sv[0], sv[1]); }
        if (fr == 0) st8bf(HB1 + (size_t)(rbase0 >> 6) * 256 + cb0, acc[1][0][0], acc[1][0][1]);
    }
};
struct EpiCmp {
    static constexpr bool HAS_MID = false; static constexpr int MID_T = 0;
    bf16_t* GH; const float* cbias;
    DI void mid(f32x4 (&)[2][2][4][2], const pg8::Unit&, int, int, int, int) const {}
    static DI float gelu(float x) { const float y = 1.5957691216057308f * (x + 0.044715f * x * x * x); return x / (1.f + __expf(-y)); }
    DI void elem(int row, int col0, f32x4 v0, f32x4 v1) const {
        v0 = v0 + *(const f32x4*)(cbias + col0); v1 = v1 + *(const f32x4*)(cbias + col0 + 4);
        f32x4 a, b; a.x = gelu(v0.x); a.y = gelu(v0.y); a.z = gelu(v0.z); a.w = gelu(v0.w); b.x = gelu(v1.x); b.y = gelu(v1.y); b.z = gelu(v1.z); b.w = gelu(v1.w);
        st8bf(GH + (size_t)row * 256 + col0, a, b);
    }
};
struct EpiBr {
    static constexpr bool HAS_MID = true; static constexpr int MID_T = 8;
    const bf16_t* GM; bf16_t* MIX;
    DI void mid(f32x4 (&acc)[2][2][4][2], const pg8::Unit& u, int wr, int wc, int fr, int fq) const {
        const bf16_t* p0 = GM + (size_t)(u.pm * 256 + wr * 64 + fr) * 2048 + u.pn * 256 + wc * 32 + 8 * fq;
        asm volatile("" : "+v"(p0));
#pragma unroll
        for (int ai = 0; ai < 2; ++ai)
#pragma unroll
            for (int m = 0; m < 4; ++m)
#pragma unroll
                for (int bj = 0; bj < 2; ++bj) { const bf16_t* p = p0 + (size_t)(ai * 128 + m * 16) * 2048 + bj * 128;
                    const u32x4 ga = *(const u32x4*)p, gb = *(const u32x4*)(p + 1024);
                    f32x4 r0, r1;
                    r0.x = bf2f(ga.x & 0xffffu) * __builtin_amdgcn_rcpf(bf2f(gb.x & 0xffffu)); r0.y = bf2f(ga.x >> 16) * __builtin_amdgcn_rcpf(bf2f(gb.x >> 16));
                    r0.z = bf2f(ga.y & 0xffffu) * __builtin_amdgcn_rcpf(bf2f(gb.y & 0xffffu)); r0.w = bf2f(ga.y >> 16) * __builtin_amdgcn_rcpf(bf2f(gb.y >> 16));
                    r1.x = bf2f(ga.z & 0xffffu) * __builtin_amdgcn_rcpf(bf2f(gb.z & 0xffffu)); r1.y = bf2f(ga.z >> 16) * __builtin_amdgcn_rcpf(bf2f(gb.z >> 16));
                    r1.z = bf2f(ga.w & 0xffffu) * __builtin_amdgcn_rcpf(bf2f(gb.w & 0xffffu)); r1.w = bf2f(ga.w >> 16) * __builtin_amdgcn_rcpf(bf2f(gb.w >> 16));
                    acc[ai][bj][m][0] = acc[ai][bj][m][0] * r0; acc[ai][bj][m][1] = acc[ai][bj][m][1] * r1; }
    }
    DI void elem(int row, int col0, f32x4 v0, f32x4 v1) const {
        const bf16_t* p = GM + (size_t)row * 2048 + 1024 + col0;
        st8bf(MIX + (size_t)row * 1024 + col0, v0 * ld4bf(p), v1 * ld4bf(p + 4));
    }
    DI void elem2(int row, int col0, f32x4 a0, f32x4 a1, f32x4 b0, f32x4 b1) const {
        const bf16_t* p = GM + (size_t)row * 2048 + col0;
        st8bf(MIX + (size_t)row * 1024 + col0, a0 * ld4bf(p) + b0 * ld4bf(p + 1024), a1 * ld4bf(p + 4) + b1 * ld4bf(p + 1028));
    }
};
struct EpiRes {
    static constexpr bool HAS_MID = false; static constexpr int MID_T = 0;
    const float *xp, *xs; bf16_t* XO; const float* mod; int goff; const bf16_t* xin;
    DI void mid(f32x4 (&)[2][2][4][2], const pg8::Unit&, int, int, int, int) const {}
    DI void elem(int row, int col0, f32x4 v0, f32x4 v1) const {
        if (row >= MREAL) return;
        const int mrow = row < MPR ? (row >> 11) : 8 + (row - MPR);
        const float* gp = mod + (size_t)mrow * 6144 + goff + col0;
        f32x4 s0, s1;
        if (xin) { s0 = ld4bf(xin + (size_t)row * D + col0); s1 = ld4bf(xin + (size_t)row * D + col0 + 4); }
        else { const float* src = row < MPR ? xp + (size_t)row * D + col0 : xs + (size_t)(row - MPR) * D + col0; s0 = *(const f32x4*)src; s1 = *(const f32x4*)(src + 4); }
        st8bf(XO + (size_t)row * D + col0, s0 + *(const f32x4*)gp * v0, s1 + *(const f32x4*)(gp + 4) * v1);
    }
};
struct EpiSwiGLU {
    static constexpr bool HAS_MID = false; static constexpr int MID_T = 0;
    bf16_t* H;
    DI void mid(f32x4 (&)[2][2][4][2], const pg8::Unit&, int, int, int, int) const {}
    DI void elem(int row, int col0, f32x4 v0, f32x4 v1) const {
        const f32x4 s = sig4(v0); const f32x4 o = v0 * s * v1; u32x2 w; w.x = pk2(o.x, o.y); w.y = pk2(o.z, o.w);
        *(u32x2*)(H + (size_t)row * FFH + (col0 >> 1)) = w;
    }
};

template <class Epi>
DI void skinny_task(LAS unsigned char* lds, const bf16_t* A, int lda, const bf16_t* Bt, int K, int n0, const Epi& E, int wave, int lane) {
    const int fr = lane & 15, fq = lane >> 4, ksl = K >> 3;
    f32x4 acc[2][2];
#pragma unroll
    for (int i = 0; i < 2; ++i) { acc[i][0] = (f32x4){0.f, 0.f, 0.f, 0.f}; acc[i][1] = acc[i][0]; }
    const bf16_t* ap = A + (size_t)fr * lda + wave * ksl + 8 * fq;
    const bf16_t* bp = Bt + (size_t)(n0 + 8 * (fr >> 2) + (fr & 3)) * K + wave * ksl + 8 * fq;
#pragma unroll 2
    for (int k = 0; k < ksl; k += 32) {
        const bf16x8 a0 = *(const bf16x8*)(ap + k), a1 = *(const bf16x8*)(ap + (size_t)16 * lda + k);
        const bf16x8 b0 = *(const bf16x8*)(bp + k), b1 = *(const bf16x8*)(bp + (size_t)4 * K + k);
        acc[0][0] = __builtin_amdgcn_mfma_f32_16x16x32_bf16(b0, a0, acc[0][0], 0, 0, 0); acc[0][1] = __builtin_amdgcn_mfma_f32_16x16x32_bf16(b1, a0, acc[0][1], 0, 0, 0);
        acc[1][0] = __builtin_amdgcn_mfma_f32_16x16x32_bf16(b0, a1, acc[1][0], 0, 0, 0); acc[1][1] = __builtin_amdgcn_mfma_f32_16x16x32_bf16(b1, a1, acc[1][1], 0, 0, 0);
    }
    LAS float* P = (LAS float*)lds;
    __syncthreads();
#pragma unroll
    for (int mt = 0; mt < 2; ++mt)
#pragma unroll
        for (int nt = 0; nt < 2; ++nt) *(LAS f32x4*)(P + (wave * 32 + 16 * mt + fr) * 32 + 8 * fq + 4 * nt) = acc[mt][nt];
    __syncthreads();
    const int tid = wave * 64 + lane;
    if (tid < 128) { const int row = tid >> 2, cg = tid & 3;
        f32x4 s[2][2];
#pragma unroll
        for (int hf = 0; hf < 2; ++hf) { s[hf][0] = (f32x4){0.f, 0.f, 0.f, 0.f}; s[hf][1] = s[hf][0];
#pragma unroll
            for (int w = 0; w < 4; ++w) { const LAS float* p = P + ((4 * hf + w) * 32 + row) * 32 + 8 * cg; s[hf][0] = s[hf][0] + *(const LAS f32x4*)p; s[hf][1] = s[hf][1] + *(const LAS f32x4*)(p + 4); } }
        if constexpr (Epi::HAS_MID) E.elem2(MPR + row, n0 + 8 * cg, s[0][0], s[0][1], s[1][0], s[1][1]);
        else E.elem(MPR + row, n0 + 8 * cg, s[0][0] + s[1][0], s[0][1] + s[1][1]); }
    __syncthreads();
}
template <class Epi>
DI void skinny_phase(LAS unsigned char* lds, const bf16_t* A, int lda, const bf16_t* Bt, int K, int N, int nunits, const Epi& E, int bx, int G, int wave, int lane) {
    const int rem = nunits % G, nlight = rem ? G - rem : G, me = G - 1 - bx;
    if (me < nlight) for (int t = me; t < N / 32; t += nlight) skinny_task<Epi>(lds, A + (size_t)MPR * lda, lda, Bt, K, 32 * t, E, wave, lane);
}
constexpr int A_KS = 0, A_VS = 16384, A_LUT = 32768, A_IMPH = 46080, A_SC = 82944, A_MASK = 91392, A_MISC = 91648;
constexpr int LUTN = 832;
DI int swz64(int row) { return (((row >> 1) & 1) << 2) | ((row >> 2) & 3); }
DI int off64(int row, int ch) { return row * 128 + ((ch ^ swz64(row)) << 4); }
DI int swz128(int row) { return ((row & 3) << 2) | ((row >> 2) & 3); }
DI int off128(int row, int ch) { return row * 256 + ((ch ^ swz128(row)) << 4); }
DI int crow(int reg, int h) { return (reg & 3) + 8 * (reg >> 2) + 4 * h; }
DI s16x4 vtr(const LAS unsigned char* p) { return __builtin_bit_cast(s16x4, __builtin_amdgcn_ds_read_tr16_b64_v4i16((LAS v4i16_t*)p)); }
#define MFMA32(a, b, c) __builtin_amdgcn_mfma_f32_32x32x16_bf16((a), (b), (c), 0, 0, 0)
template <int S> DI bf16x8 pack_step(const f32x16& x) { u32x4 p; p.x = pk2(x[8 * S], x[8 * S + 1]); p.y = pk2(x[8 * S + 2], x[8 * S + 3]); p.z = pk2(x[8 * S + 4], x[8 * S + 5]); p.w = pk2(x[8 * S + 6], x[8 * S + 7]); return __builtin_bit_cast(bf16x8, p); }
DI f32x16 zero16() { f32x16 z; for (int i = 0; i < 16; ++i) z[i] = 0.f; return z; }
DI int rel_bucket(int d) {
    if (d < 16) return d < 0 ? 0 : d;
    int b = 16;
    b += (d >= 21) + (d >= 27) + (d >= 35) + (d >= 46) + (d >= 59) + (d >= 77) + (d >= 99) + (d >= 128) + (d >= 166) + (d >= 216) + (d >= 280) + (d >= 363) + (d >= 470) + (d >= 609) + (d >= 790);
    return b;
}
DI f32x16 qk64_rb(const LAS unsigned char* Ks, int rb, const bf16x8 (&qf)[4], int r, int h2) {
    f32x16 s = zero16();
#pragma unroll
    for (int ks = 0; ks < 4; ++ks) { const bf16x8 kf = *(const LAS bf16x8*)(Ks + off64(32 * rb + r, 2 * ks + h2)); s = MFMA32(kf, qf[ks], s); }
    return s;
}
DI void pv64_rb(f32x16 (&O)[2], const f32x16& P, const LAS unsigned char* Vs, int rb, int lane) {
    const int i16 = lane & 15, q = i16 >> 2, p = i16 & 3, blk = (lane >> 4) & 1, h2 = lane >> 5;
    const bf16x8 pb0 = pack_step<0>(P), pb1 = pack_step<1>(P);
#pragma unroll
    for (int s = 0; s < 2; ++s) {
        const int rlo = 32 * rb + 16 * s + 4 * h2 + q;
#pragma unroll
        for (int db = 0; db < 2; ++db) { const int dcol = 32 * db + 16 * blk + 4 * p, ch = dcol >> 3, sub = (dcol & 7) * 2;
            const s16x4 lo = vtr(Vs + off64(rlo, ch) + sub), hi = vtr(Vs + off64(rlo + 8, ch) + sub);
            const bf16x8 va = __builtin_shufflevector(lo, hi, 0, 1, 2, 3, 4, 5, 6, 7);
            O[db] = MFMA32(va, s == 0 ? pb0 : pb1, O[db]); }
    }
}
constexpr int LUTR_N = 992, LOFF = 915;
constexpr int N_KT0 = 0, N_VT0 = 8192, N_KT1 = 16384, N_VT1 = 24576, N_LUT = 32768, N_IMPH = N_LUT + 2 * 4 * LUTR_N * 4, N_SC = 0, N_E0 = N_IMPH + 4 * 64 * 33 * 4, N_E1 = N_E0 + 16384, N_MASK = N_E1 + 16384, N_END = N_MASK + 512;
static_assert(N_END <= 139264, "NSA LDS map");
constexpr float RESC_THR = 8.f;
DI float ex2(float x) { return __builtin_amdgcn_exp2f(x); }
DI float pairmax32(float x) { const unsigned u = __builtin_bit_cast(unsigned, x); const auto r = __builtin_amdgcn_permlane32_swap(u, u, false, false);
    return fmaxf(__builtin_bit_cast(float, r[0]), __builtin_bit_cast(float, r[1])); }
DI float max3f(float a, float b, float c) { return fmaxf(fmaxf(a, b), c); }
template <bool NEAR, int MASK>
DI void nsa_tile2(f32x16 (&O)[2], float& l, float& inited, f32x16& negm, const LAS unsigned char* Kb, const LAS unsigned char* Vb, const int (&ka)[4], const int (&va)[4], const bf16x8 (&qf)[4],
                  const LAS float* lutp, float c31, int dlim, bool tok) {
    f32x16 S[2];
#pragma unroll
    for (int rb = 0; rb < 2; ++rb) { const bf16x8 kf0 = *(const LAS bf16x8*)(Kb + ka[0] + rb * 4096); S[rb] = MFMA32(kf0, qf[0], negm);
#pragma unroll
        for (int ks = 1; ks < 4; ++ks) { const bf16x8 kf = *(const LAS bf16x8*)(Kb + ka[ks] + rb * 4096); S[rb] = MFMA32(kf, qf[ks], S[rb]); } }
    float mx = -INFINITY;
#pragma unroll
    for (int rb = 0; rb < 2; ++rb)
#pragma unroll
        for (int reg = 0; reg < 16; ++reg) { const int c = 32 * rb + (reg & 3) + 8 * (reg >> 2); float sv = S[rb][reg];
            if (NEAR) sv += lutp[c]; else sv += c31;
            if (MASK == 1) sv = c <= dlim ? sv : -INFINITY;
            if (MASK == 2) sv = c > dlim - 512 ? sv : -INFINITY;
            S[rb][reg] = sv; mx = fmaxf(mx, sv); }
    mx = tok ? mx : -INFINITY;
    mx = pairmax32(mx);
    const bool need = mx > RESC_THR || (inited == 0.f && mx > -INFINITY);
    if (__builtin_amdgcn_ballot_w64(need) != 0ull) {
        float delta = 0.f;
        if (mx > -INFINITY) { delta = inited == 0.f ? mx : fmaxf(mx, 0.f); inited = 1.f; }
        const float alpha = ex2(-delta);
        l *= alpha;
#pragma unroll
        for (int reg = 0; reg < 16; ++reg) { O[0][reg] *= alpha; O[1][reg] *= alpha; negm[reg] -= delta; S[0][reg] -= delta; S[1][reg] -= delta; }
    }
    float ls = 0.f;
#pragma unroll
    for (int rb = 0; rb < 2; ++rb)
#pragma unroll
        for (int reg = 0; reg < 16; ++reg) { const float p = ex2(S[rb][reg]); S[rb][reg] = p; ls += p; }
    ls = tok ? ls : 0.f;
    l += ls;
    const unsigned pmask = tok ? 0xffffffffu : 0u;
#pragma unroll
    for (int rb = 0; rb < 2; ++rb) {
        u32x4 pa = __builtin_bit_cast(u32x4, pack_step<0>(S[rb])), pb = __builtin_bit_cast(u32x4, pack_step<1>(S[rb]));
        pa.x &= pmask; pa.y &= pmask; pa.z &= pmask; pa.w &= pmask; pb.x &= pmask; pb.y &= pmask; pb.z &= pmask; pb.w &= pmask;
#pragma unroll
        for (int s = 0; s < 2; ++s)
#pragma unroll
            for (int db = 0; db < 2; ++db) {
                const s16x4 lo = vtr(Vb + va[db] + rb * 4096 + s * 2048), hi = vtr(Vb + va[2 + db] + rb * 4096 + s * 2048);
                const bf16x8 vf = __builtin_shufflevector(lo, hi, 0, 1, 2, 3, 4, 5, 6, 7);
                O[db] = MFMA32(vf, __builtin_bit_cast(bf16x8, s == 0 ? pa : pb), O[db]); }
    }
}
DI void nsa_acc_out(f32x16 (&OUT)[2], const f32x16 (&O)[2], float l, float gate) {
    const float lt = l + __shfl_xor(l, 32); const float sc = gate / fmaxf(lt, 1e-30f);
#pragma unroll
    for (int db = 0; db < 2; ++db)
#pragma unroll
        for (int reg = 0; reg < 16; ++reg) OUT[db][reg] += O[db][reg] * sc;
}
DI void nsa_unit(const Args& a, LAS unsigned char* lds, int b, int g, int jb) {
    unsigned char* ws = a.ws;
    int tid_ = threadIdx.x; asm volatile("" : "+v"(tid_));
    const int tid = tid_, lane = tid & 63, wave = __builtin_amdgcn_readfirstlane(tid >> 6), hh = wave & 3, th = wave >> 2, r = lane & 31, h2 = lane >> 5;
    const int q0 = 64 * jb, tl = 32 * th + r, t = q0 + tl; const size_t row = (size_t)b * T + t;
    const bf16_t* QA = (const bf16_t*)(ws + WS_QA); const bf16_t* KVB = (const bf16_t*)(ws + WS_KVB); const bf16_t* KC = (const bf16_t*)(ws + WS_KC);
    LAS float* LUT = (LAS float*)(lds + N_LUT); LAS float* IMPH = (LAS float*)(lds + N_IMPH); LAS float* SC = (LAS float*)(lds + N_SC); LAS unsigned* MASK = (LAS unsigned*)(lds + N_MASK); LAS unsigned* ANYW = (LAS unsigned*)(lds + N_MASK + 256);
    const float* rbp = INF(a, I_RB);
    __syncthreads();
    if (tid == 0) *ANYW = 0u;
    const bf16_t* ksb = KVB + (size_t)b * T * 512 + g * 64;
    const int drow = 8 * wave + (lane >> 3), dgoff = drow * 512 + (((lane & 7) ^ swz64(drow)) << 3);
#define NSA_SLOT(sidx) ((sidx) == 0 ? N_E0 : ((sidx) == 1 ? N_E1 : ((sidx) < 4 ? ((sidx) - 2) * 16384 : N_IMPH + ((sidx) - 4) * 16384)))
#define NSA_DMA(isw, tile, sidx) do { const int so_ = NSA_SLOT(sidx); const bf16_t* kb_ = ksb + ((isw) ? 256 : 0) + dgoff + (size_t)(64 * (tile)) * 512; \
        __builtin_amdgcn_global_load_lds((const unsigned*)kb_, (LAS unsigned*)(lds + so_ + wave * 1024), 16, 0, 0); \
        __builtin_amdgcn_global_load_lds((const unsigned*)(kb_ + 128), (LAS unsigned*)(lds + so_ + 8192 + wave * 1024), 16, 0, 0); } while (0)
    const unsigned upto = jb == 31 ? 0xffffffffu : ((2u << jb) - 1u);
    unsigned pfw = upto & ~((1u << (jb > 8 ? jb - 8 : 0)) - 1u);
    int spf = 0;
#pragma unroll 1
    for (int n = 0; n < 2; ++n) if (pfw) { const int tp = __builtin_ctz(pfw); pfw &= pfw - 1u; NSA_DMA(true, tp, spf); ++spf; }
    volatile LAS int* LUTG = (volatile LAS int*)(lds + RING_BYTES + 128);
    LUT += g * 4 * LUTR_N;
    if (__builtin_amdgcn_readfirstlane(LUTG[g]) == 0) {
        for (int i = tid; i < 4 * LUTR_N; i += 512) { const int h = i / LUTR_N, x = i - h * LUTR_N, d = LOFF - x; LUT[i] = d >= 0 ? rbp[rel_bucket(d) * 8 + g * 4 + h] * LOG2E : 0.f; }
        __syncthreads();
        if (tid == 0) LUTG[g] = 1;
    }
    { const bf16_t* kc = KC + ((size_t)(b * 2 + g) * 128) * 64; const bf16_t* vc = kc + (size_t)AROWS * 64;
#pragma unroll
      for (int i = 0; i < 2; ++i) { const int idx = tid + 512 * i, rw = idx >> 3, ch = idx & 7;
          *(LAS u32x4*)(lds + off64(rw, ch)) = *(const u32x4*)(kc + (size_t)rw * 64 + ch * 8); *(LAS u32x4*)(lds + 16384 + off64(rw, ch)) = *(const u32x4*)(vc + (size_t)rw * 64 + ch * 8); } }
    bf16x8 qf[4];
#pragma unroll
    for (int ks = 0; ks < 4; ++ks) qf[ks] = *(const bf16x8*)(QA + row * 512 + (g * 4 + hh) * 64 + 16 * ks + 8 * h2);
    const float* ga = (const float*)(ws + WS_GA) + row * 32 + (g * 4 + hh) * 3;
    const float gate_c = ga[0], gate_s = ga[1], gate_w = ga[2];
    const float c31 = rbp[31 * 8 + g * 4 + hh] * LOG2E;
    const LAS float* lut = LUT + hh * LUTR_N;
    __syncthreads();
    float* oscr = (float*)(ws + WS_NSCR) + ((size_t)(blockIdx.x * 8 + wave) * 32) * 64 + lane;
    {
        f32x16 OUT[2]; OUT[0] = zero16(); OUT[1] = zero16();
        const LAS unsigned char* Ks = lds; const LAS unsigned char* Vs = lds + 16384;
        f32x16 S[4];
#pragma unroll
        for (int rb = 0; rb < 4; ++rb) S[rb] = qk64_rb(Ks, rb, qf, r, h2);
        float mx = -INFINITY;
#pragma unroll
        for (int rb = 0; rb < 4; ++rb)
#pragma unroll
            for (int reg = 0; reg < 16; ++reg) { const int i = 32 * rb + crow(reg, h2), dist = t - (16 * i + 31);
                const bool valid = dist >= 0 && i < 127; const int xi = dist < 0 ? LOFF + 1 : LOFF - (dist > LOFF ? LOFF : dist);
                const float sv = valid ? S[rb][reg] + lut[xi] : -INFINITY; S[rb][reg] = sv; mx = fmaxf(mx, sv); }
        mx = fmaxf(mx, __shfl_xor(mx, 32));
        const float ms = mx == -INFINITY ? 0.f : mx;
        float ls = 0.f;
#pragma unroll
        for (int rb = 0; rb < 4; ++rb)
#pragma unroll
            for (int reg = 0; reg < 16; ++reg) { const float p = ex2(S[rb][reg] - ms); S[rb][reg] = p; ls += p; }
        ls += __shfl_xor(ls, 32);
        const float inv = ls > 0.f ? 1.f / fmaxf(ls, 1e-30f) : 0.f;
#pragma unroll
        for (int rb = 0; rb < 4; ++rb)
#pragma unroll
            for (int reg = 0; reg < 16; ++reg) S[rb][reg] *= inv;
        LAS float* ip = IMPH + (hh * 64 + tl) * 33;
#pragma unroll
        for (int rb = 0; rb < 4; ++rb)
#pragma unroll
            for (int rg = 0; rg < 4; ++rg) ip[8 * rb + 2 * rg + h2] = (S[rb][4 * rg] + S[rb][4 * rg + 1]) + (S[rb][4 * rg + 2] + S[rb][4 * rg + 3]);
        if (h2 == 0) ip[32] = 0.f;
        LDS_WAIT(); asm volatile("" ::: "memory");
        {
            float cv[16];
#pragma unroll
            for (int rb = 0; rb < 4; ++rb)
#pragma unroll
                for (int rg = 0; rg < 4; ++rg) cv[4 * rb + rg] = ip[8 * rb + 2 * rg + h2 + 1];
            LDS_WAIT(); asm volatile("" ::: "memory");
#pragma unroll
            for (int rb = 0; rb < 4; ++rb)
#pragma unroll
                for (int rg = 0; rg < 4; ++rg) ip[8 * rb + 2 * rg + h2 + 1] = cv[4 * rb + rg] + S[rb][4 * rg + 3];
        }
#pragma unroll
        for (int rb = 0; rb < 4; ++rb) {
#pragma unroll
            for (int reg = 0; reg < 16; ++reg) S[rb][reg] *= gate_c;
            pv64_rb(OUT, S[rb], Vs, rb, lane); }
#pragma unroll
        for (int db = 0; db < 2; ++db)
#pragma unroll
            for (int reg = 0; reg < 16; ++reg) oscr[(db * 16 + reg) * 64] = OUT[db][reg];
    }
    __syncthreads();
    if (jb >= 16) {
        for (int idx = tid; idx < 64 * 32; idx += 512) { const int tk = idx >> 5, j = idx & 31;
            const float imp = (IMPH[(0 * 64 + tk) * 33 + j] + IMPH[(1 * 64 + tk) * 33 + j]) + (IMPH[(2 * 64 + tk) * 33 + j] + IMPH[(3 * 64 + tk) * 33 + j]);
            const bool valid = j <= jb, forced = (j == 0) || (j == jb) || (j == jb - 1);
            SC[tk * 33 + j] = valid ? (forced ? 1e9f : imp) : -1e30f; }
        __syncthreads();
        for (int idx = tid; idx < 64 * 32; idx += 512) { const int tk = idx >> 5, j = idx & 31; const float my = SC[tk * 33 + j]; int rank = 0;
#pragma unroll 8
            for (int k = 0; k < 32; ++k) { const float o = SC[tk * 33 + k]; rank += (o > my || (o == my && k < j)) ? 1 : 0; }
            const bool sel = rank < 16 && j <= jb;
            const unsigned long long bal = __ballot(sel);
            if (j == 0) { const unsigned mk = (unsigned)(bal >> (32 * (lane >> 5))); MASK[tk] = mk; __hip_atomic_fetch_or(ANYW, mk, __ATOMIC_RELAXED, __HIP_MEMORY_SCOPE_WORKGROUP); } }
    } else if (tid < 64) { MASK[tid] = (2u << jb) - 1u; if (tid == 0) *ANYW = (2u << jb) - 1u; }
    __syncthreads();
    const unsigned tmask = MASK[tl];
    const unsigned any = __builtin_amdgcn_readfirstlane(*ANYW);
    int ka[4], va[4];
    { const int i16 = lane & 15, q = i16 >> 2, p4 = i16 & 3, blk = (lane >> 4) & 1;
#pragma unroll
      for (int ks = 0; ks < 4; ++ks) ka[ks] = off64(r, 2 * ks + h2);
#pragma unroll
      for (int hi = 0; hi < 2; ++hi)
#pragma unroll
          for (int db = 0; db < 2; ++db) { const int dcol = 32 * db + 16 * blk + 4 * p4; va[2 * hi + db] = off64(4 * h2 + q + 8 * hi, dcol >> 3) + (dcol & 7) * 2; } }
    {
        unsigned remw = upto & ~((1u << (jb > 8 ? jb - 8 : 0)) - 1u), rems = any & upto;
        unsigned pfs = rems;
        int scur = 0;
        f32x16 O[2]; O[0] = zero16(); O[1] = zero16(); float l = 0.f, inited = 0.f;
        f32x16 negm = zero16();
        bool in_win = true;
        VM_WAIT();
        __syncthreads();
        { if (pfw) { const int tp = __builtin_ctz(pfw); pfw &= pfw - 1u; NSA_DMA(true, tp, spf); spf = spf == 5 ? 0 : spf + 1; }
          else if (pfs) { const int tp = __builtin_ctz(pfs); pfs &= pfs - 1u; NSA_DMA(false, tp, spf); spf = spf == 5 ? 0 : spf + 1; } }
        while (remw | rems) {
            const bool isw = remw != 0u;
            if (!isw && in_win) {
                const float lt = l + __shfl_xor(l, 32); const float sc = gate_w / fmaxf(lt, 1e-30f);
#pragma unroll
                for (int db = 0; db < 2; ++db)
#pragma unroll
                    for (int reg = 0; reg < 16; ++reg) oscr[(db * 16 + reg) * 64] += O[db][reg] * sc;
                O[0] = zero16(); O[1] = zero16(); l = 0.f; inited = 0.f; negm = zero16(); in_win = false;
            }
            int kt;
            if (isw) { kt = __builtin_ctz(remw); remw &= remw - 1u; } else { kt = __builtin_ctz(rems); rems &= rems - 1u; }
            bool issued = false;
            if (pfw) { const int tp = __builtin_ctz(pfw); pfw &= pfw - 1u; NSA_DMA(true, tp, spf); spf = spf == 5 ? 0 : spf + 1; issued = true; }
            else if (pfs) { const int tp = __builtin_ctz(pfs); pfs &= pfs - 1u; NSA_DMA(false, tp, spf); spf = spf == 5 ? 0 : spf + 1; issued = true; }
            int boff = NSA_SLOT(scur);
            asm volatile("" : "+s"(boff));
            const LAS unsigned char* Kb = lds + boff; const LAS unsigned char* Vb = Kb + 8192;
            const int key0 = 64 * kt, dlim = t - key0 - 4 * h2;
            const LAS float* lutp = lut + (LOFF - dlim);
            const bool tok = isw ? true : ((tmask >> kt) & 1u) != 0u;
            if (__ballot(tok) != 0ull) {
                if (kt == jb) nsa_tile2<true, 1>(O, l, inited, negm, Kb, Vb, ka, va, qf, lutp, c31, dlim, tok);
                else if (isw && kt == jb - 8) nsa_tile2<true, 2>(O, l, inited, negm, Kb, Vb, ka, va, qf, lutp, c31, dlim, tok);
                else if (!isw && key0 + 63 + 790 <= q0 + 32 * th) nsa_tile2<false, 0>(O, l, inited, negm, Kb, Vb, ka, va, qf, lutp, c31, dlim, tok);
                else nsa_tile2<true, 0>(O, l, inited, negm, Kb, Vb, ka, va, qf, lutp, c31, dlim, tok);
            }
            if (issued) asm volatile("s_waitcnt vmcnt(4)" ::: "memory"); else VM_WAIT();
            __syncthreads();
            scur = scur == 5 ? 0 : scur + 1;
        }
        {
            const float lt = l + __shfl_xor(l, 32); const float sc = gate_s / fmaxf(lt, 1e-30f);
            bf16_t* op = (bf16_t*)(ws + WS_OAHB) + row * 1024 + (g * 4 + hh) * 64;
#pragma unroll
            for (int db = 0; db < 2; ++db)
#pragma unroll
                for (int rg = 0; rg < 4; ++rg) { float o[4];
#pragma unroll
                    for (int i = 0; i < 4; ++i) o[i] = oscr[(db * 16 + 4 * rg + i) * 64] + O[db][4 * rg + i] * sc;
                    u32x2 w; w.x = pk2(o[0], o[1]); w.y = pk2(o[2], o[3]); *(u32x2*)(op + 32 * db + 8 * rg + 4 * h2) = w; }
        }
    }
#undef NSA_SLOT
#undef NSA_DMA
}

constexpr int M_BS = 32768, M_KAP = 33024, M_NV = 33280, M_CT = 36864;
DI void mlstm_unit(const Args& a, LAS unsigned char* lds, int b, int h, int J) {
    unsigned char* ws = a.ws;
    int tid_ = threadIdx.x; asm volatile("" : "+v"(tid_));
    const int tid = tid_, lane = tid & 63, wave = __builtin_amdgcn_readfirstlane(tid >> 6), r = lane & 31, h2 = lane >> 5;
    const int seq = b * 4 + h, t = 256 * J + 32 * wave + r; const size_t row = (size_t)b * T + t;
    const bf16_t* QB = (const bf16_t*)(ws + WS_QB); const bf16_t* KB = (const bf16_t*)(ws + WS_KB) + (size_t)b * T * 512 + h * 128; const bf16_t* VB = (const bf16_t*)(ws + WS_VB) + (size_t)b * T * 512 + h * 128;
    const float* BETA = (const float*)(ws + WS_BETA) + seq * 2048; const float* ALPHA = (const float*)(ws + WS_ALPHA) + seq * 2048; const float* MTG = (const float*)(ws + WS_MT) + seq * 2048;
    const LAS unsigned char* Ks = lds + A_KS; const LAS unsigned char* Vs = lds + A_VS; LAS float* BS = (LAS float*)(lds + M_BS); LAS float* KAP = (LAS float*)(lds + M_KAP); LAS float* NV = (LAS float*)(lds + M_NV);
    bf16x8 qf[8];
#pragma unroll
    for (int ks = 0; ks < 8; ++ks) qf[ks] = *(const bf16x8*)(QB + row * 512 + h * 128 + 16 * ks + 8 * h2);
    const float aln = ALPHA[t], al = aln * LOG2E, mt = MTG[t];
    f32x16 O[4];
#pragma unroll
    for (int i = 0; i < 4; ++i) O[i] = zero16();
    float den = 0.f;
    __syncthreads();
    if (J > 0) {
        const int e1 = 256 * J - 1;
        if (tid < J) { const int ep = 256 * tid + 255; const float Be1 = ALPHA[e1] + MTG[e1], Bep = ALPHA[ep] + MTG[ep];
            KAP[tid] = __expf((Be1 - Bep) + ((const float*)(ws + WS_MU))[seq * 8 + tid] - MTG[e1]); }
        __syncthreads();
        {
            f32x4 cacc[8];
#pragma unroll
            for (int i = 0; i < 8; ++i) cacc[i] = (f32x4){0.f, 0.f, 0.f, 0.f};
            float nacc = 0.f;
            const float* dc = (const float*)(ws + WS_DC) + (size_t)seq * 8 * 16384 + tid * 4; const float* dn = (const float*)(ws + WS_DN) + seq * 8 * 128;
#pragma unroll 2
            for (int jp = 0; jp < J; ++jp) { const float f = KAP[jp];
#pragma unroll
                for (int i = 0; i < 8; ++i) cacc[i] = cacc[i] + *(const f32x4*)(dc + (size_t)jp * 16384 + 2048 * i) * f;
                if (tid < 128) nacc += dn[jp * 128 + tid] * f; }
#pragma unroll
            for (int i = 0; i < 8; ++i) { const int e = (tid + 512 * i) * 4, dk = e >> 7, dv = e & 127;
#pragma unroll
                for (int j = 0; j < 4; ++j) *(LAS unsigned short*)(lds + M_CT + off128(dv + j, dk >> 3) + (dk & 7) * 2) = (unsigned short)(pk2(cacc[i][j], 0.f) & 0xffffu); }
            if (tid < 128) NV[tid] = nacc;
        }
        __syncthreads();
#pragma unroll
        for (int db = 0; db < 4; ++db)
#pragma unroll
            for (int ks = 0; ks < 8; ++ks) { const bf16x8 cf = *(const LAS bf16x8*)(lds + M_CT + off128(32 * db + r, 2 * ks + h2)); O[db] = MFMA32(cf, qf[ks], O[db]); }
        const float sc = __expf(aln - ALPHA[e1]);
#pragma unroll
        for (int db = 0; db < 4; ++db)
#pragma unroll
            for (int reg = 0; reg < 16; ++reg) O[db][reg] *= sc;
        float qn = 0.f;
#pragma unroll
        for (int ks = 0; ks < 8; ++ks) { const u32x4 qw = __builtin_bit_cast(u32x4, qf[ks]); const f32x4 n0 = *(const LAS f32x4*)(NV + 16 * ks + 8 * h2), n1 = *(const LAS f32x4*)(NV + 16 * ks + 8 * h2 + 4);
            qn += bf2f(qw.x & 0xffffu) * n0.x + bf2f(qw.x >> 16) * n0.y + bf2f(qw.y & 0xffffu) * n0.z + bf2f(qw.y >> 16) * n0.w + bf2f(qw.z & 0xffffu) * n1.x + bf2f(qw.z >> 16) * n1.y + bf2f(qw.w & 0xffffu) * n1.z + bf2f(qw.w >> 16) * n1.w; }
        den = sc * qn;
    }
    const int kt0 = 4 * J, my_last = 4 * J + (wave >> 1);
    const int i16 = lane & 15, q = i16 >> 2, p = i16 & 3, blk = (lane >> 4) & 1;
    u32x4 kreg[2], vreg[2]; float breg = 0.f;
#pragma unroll
    for (int i = 0; i < 2; ++i) { const int idx = tid + 512 * i, rw = 64 * kt0 + (idx >> 4), ch = idx & 15; kreg[i] = *(const u32x4*)(KB + (size_t)rw * 512 + ch * 8); vreg[i] = *(const u32x4*)(VB + (size_t)rw * 512 + ch * 8); }
    if (tid < 64) breg = BETA[64 * kt0 + tid];
#pragma unroll 1
    for (int kt = kt0; kt < kt0 + 4; ++kt) {
        __syncthreads();
#pragma unroll
        for (int i = 0; i < 2; ++i) { const int idx = tid + 512 * i, rw = idx >> 4, ch = idx & 15; *(LAS u32x4*)(lds + A_KS + off128(rw, ch)) = kreg[i]; *(LAS u32x4*)(lds + A_VS + off128(rw, ch)) = vreg[i]; }
        if (tid < 64) BS[tid] = breg * LOG2E;
        __syncthreads();
        if (kt + 1 < kt0 + 4) {
#pragma unroll
            for (int i = 0; i < 2; ++i) { const int idx = tid + 512 * i, rw = 64 * (kt + 1) + (idx >> 4), ch = idx & 15; kreg[i] = *(const u32x4*)(KB + (size_t)rw * 512 + ch * 8); vreg[i] = *(const u32x4*)(VB + (size_t)rw * 512 + ch * 8); }
            if (tid < 64) breg = BETA[64 * (kt + 1) + tid];
        }
        if (kt <= my_last) {
            f32x16 S[2];
#pragma unroll
            for (int rb = 0; rb < 2; ++rb) { S[rb] = zero16();
#pragma unroll
                for (int ks = 0; ks < 8; ++ks) { const bf16x8 kf = *(const LAS bf16x8*)(Ks + off128(32 * rb + r, 2 * ks + h2)); S[rb] = MFMA32(kf, qf[ks], S[rb]); } }
            const bool diag = kt == my_last;
#pragma unroll
            for (int rb = 0; rb < 2; ++rb)
#pragma unroll
                for (int rg = 0; rg < 4; ++rg) { const f32x4 bv = *(const LAS f32x4*)(BS + 32 * rb + 8 * rg + 4 * h2);
#pragma unroll
                    for (int i = 0; i < 4; ++i) { const int key = 64 * kt + 32 * rb + 8 * rg + 4 * h2 + i; float w = ex2(al + bv[i]); if (diag && key > t) w = 0.f;
                        const float sv = S[rb][4 * rg + i] * w; S[rb][4 * rg + i] = sv; den += sv; } }
#pragma unroll
            for (int rb = 0; rb < 2; ++rb) {
                const bf16x8 pb0 = pack_step<0>(S[rb]), pb1 = pack_step<1>(S[rb]);
#pragma unroll
                for (int s = 0; s < 2; ++s) { const int rlo = 32 * rb + 16 * s + 4 * h2 + q;
#pragma unroll
                    for (int db = 0; db < 4; ++db) { const int dcol = 32 * db + 16 * blk + 4 * p, ch = dcol >> 3, sub = (dcol & 7) * 2;
                        const s16x4 lo = vtr(Vs + off128(rlo, ch) + sub), hi = vtr(Vs + off128(rlo + 8, ch) + sub);
                        const bf16x8 va = __builtin_shufflevector(lo, hi, 0, 1, 2, 3, 4, 5, 6, 7);
                        O[db] = MFMA32(va, s == 0 ? pb0 : pb1, O[db]); } }
            }
        }
    }
    den += __shfl_xor(den, 32);
    const float inv = 1.f / fmaxf(fabsf(den), __expf(-mt));
    float s1 = 0.f;
#pragma unroll
    for (int db = 0; db < 4; ++db)
#pragma unroll
        for (int reg = 0; reg < 16; ++reg) { O[db][reg] *= inv; s1 += O[db][reg]; }
    s1 += __shfl_xor(s1, 32);
    const float mu = s1 * (1.f / 128.f);
    float s2 = 0.f;
#pragma unroll
    for (int db = 0; db < 4; ++db)
#pragma unroll
        for (int reg = 0; reg < 16; ++reg) { const float dlt = O[db][reg] - mu; s2 += dlt * dlt; }
    s2 += __shfl_xor(s2, 32);
    const float rstd = 1.f / sqrtf(s2 * (1.f / 128.f) + EPS);
    const float* gn = INF(a, I_GNORM) + h * 128; const bf16_t* ob = (const bf16_t*)(ws + WS_OB) + row * 512 + h * 128; bf16_t* op = (bf16_t*)(ws + WS_OAHB) + row * 1024 + 512 + h * 128;
#pragma unroll
    for (int db = 0; db < 4; ++db)
#pragma unroll
        for (int rg = 0; rg < 4; ++rg) { const int dv = 32 * db + 8 * rg + 4 * h2; const f32x4 g4 = *(const f32x4*)(gn + dv), o4 = ld4bf(ob + dv);
            u32x2 w; w.x = pk2((O[db][4 * rg] - mu) * rstd * g4.x * o4.x, (O[db][4 * rg + 1] - mu) * rstd * g4.y * o4.y);
            w.y = pk2((O[db][4 * rg + 2] - mu) * rstd * g4.z * o4.z, (O[db][4 * rg + 3] - mu) * rstd * g4.w * o4.w); *(u32x2*)(op + dv) = w; }
    __syncthreads();
}

DI void mblk_unit(const Args& a, LAS unsigned char* lds, int b, int h, int J) {
    unsigned char* ws = a.ws;
    int tid_ = threadIdx.x; asm volatile("" : "+v"(tid_));
    const int tid = tid_, lane = tid & 63, wave = __builtin_amdgcn_readfirstlane(tid >> 6), h2 = lane >> 5;
    const int seq = b * 4 + h, dkb = wave & 3, dvh = wave >> 2;
    const bf16_t* KB = (const bf16_t*)(ws + WS_KB) + ((size_t)b * T + 256 * J) * 512 + h * 128; const bf16_t* VB = (const bf16_t*)(ws + WS_VB) + ((size_t)b * T + 256 * J) * 512 + h * 128;
    const LAS unsigned char* Ks = lds + A_KS; const LAS unsigned char* Vs = lds + A_VS; LAS float* WL = (LAS float*)(lds + 32768); LAS float* NR = (LAS float*)(lds + 36864);
    const int i16 = lane & 15, q = i16 >> 2, p = i16 & 3, blk = (lane >> 4) & 1;
    __syncthreads();
    if (wave == 0) {
        const float* ga = (const float*)(ws + WS_GA) + ((size_t)b * T + 256 * J + lane) * 32;
        float ipv[4], bl[4];
#pragma unroll
        for (int c = 0; c < 4; ++c) { ipv[c] = ga[(size_t)c * 64 * 32 + 24 + h]; bl[c] = ga[(size_t)c * 64 * 32 + 28 + h]; }
        float Bc = 0.f;
#pragma unroll
        for (int c = 0; c < 4; ++c) { const float fp = bl[c]; float lf = fminf(fp, 0.f) - log1pf(__expf(-fabsf(fp)));
#pragma unroll
            for (int o = 1; o < 64; o <<= 1) { const float u = __shfl_up(lf, o); if (lane >= o) lf += u; }
            bl[c] = Bc + lf; Bc = __shfl(bl[c], 63); }
        float mx = -INFINITY;
#pragma unroll
        for (int c = 0; c < 4; ++c) { ipv[c] = Bc - bl[c] + ipv[c]; mx = fmaxf(mx, ipv[c]); }
        mx = wave_max(mx);
#pragma unroll
        for (int c = 0; c < 4; ++c) WL[64 * c + lane] = __expf(ipv[c] - mx);
        if (lane == 0) ((float*)(ws + WS_MU))[seq * 8 + J] = mx;
    }
    f32x16 acc[2]; acc[0] = zero16(); acc[1] = zero16();
    float nacc = 0.f; const int ndk = tid & 127, npart = tid >> 7;
    u32x4 kreg[2], vreg[2];
#pragma unroll
    for (int i = 0; i < 2; ++i) { const int idx = tid + 512 * i, rw = idx >> 4, ch = idx & 15; kreg[i] = *(const u32x4*)(KB + (size_t)rw * 512 + ch * 8); vreg[i] = *(const u32x4*)(VB + (size_t)rw * 512 + ch * 8); }
#pragma unroll 1
    for (int kt = 0; kt < 4; ++kt) {
        __syncthreads();
#pragma unroll
        for (int i = 0; i < 2; ++i) { const int idx = tid + 512 * i, rw = idx >> 4, ch = idx & 15; const float w = WL[64 * kt + rw];
            u32x4 k = kreg[i];
            k.x = pk2(bf2f(k.x & 0xffffu) * w, bf2f(k.x >> 16) * w); k.y = pk2(bf2f(k.y & 0xffffu) * w, bf2f(k.y >> 16) * w); k.z = pk2(bf2f(k.z & 0xffffu) * w, bf2f(k.z >> 16) * w); k.w = pk2(bf2f(k.w & 0xffffu) * w, bf2f(k.w >> 16) * w);
            *(LAS u32x4*)(lds + A_KS + off128(rw, ch)) = k; *(LAS u32x4*)(lds + A_VS + off128(rw, ch)) = vreg[i]; }
        __syncthreads();
        if (kt + 1 < 4) {
#pragma unroll
            for (int i = 0; i < 2; ++i) { const int idx = tid + 512 * i, rw = 64 * (kt + 1) + (idx >> 4), ch = idx & 15; kreg[i] = *(const u32x4*)(KB + (size_t)rw * 512 + ch * 8); vreg[i] = *(const u32x4*)(VB + (size_t)rw * 512 + ch * 8); }
        }
#pragma unroll
        for (int i = 0; i < 16; ++i) { const int rw = npart * 16 + i; nacc += bf2f(*(const LAS unsigned short*)(Ks + off128(rw, ndk >> 3) + (ndk & 7) * 2)); }
#pragma unroll
        for (int ss = 0; ss < 4; ++ss) { const int rlo = 16 * ss + 8 * h2 + q;
            const int kcol = 32 * dkb + 16 * blk + 4 * p, kch = kcol >> 3, ksub = (kcol & 7) * 2;
            const s16x4 klo = vtr(Ks + off128(rlo, kch) + ksub), khi = vtr(Ks + off128(rlo + 4, kch) + ksub);
            const bf16x8 ka = __builtin_shufflevector(klo, khi, 0, 1, 2, 3, 4, 5, 6, 7);
#pragma unroll
            for (int e = 0; e < 2; ++e) { const int vcol = 32 * (2 * dvh + e) + 16 * blk + 4 * p, vch = vcol >> 3, vsub = (vcol & 7) * 2;
                const s16x4 vlo = vtr(Vs + off128(rlo, vch) + vsub), vhi = vtr(Vs + off128(rlo + 4, vch) + vsub);
                const bf16x8 vbf = __builtin_shufflevector(vlo, vhi, 0, 1, 2, 3, 4, 5, 6, 7);
                acc[e] = MFMA32(ka, vbf, acc[e]); } }
    }
    float* co = (float*)(ws + WS_DC) + (size_t)(seq * 8 + J) * 16384;
#pragma unroll
    for (int e = 0; e < 2; ++e)
#pragma unroll
        for (int reg = 0; reg < 16; ++reg) co[(size_t)(32 * dkb + crow(reg, h2)) * 128 + 32 * (2 * dvh + e) + (lane & 31)] = acc[e][reg];
    __syncthreads();
    NR[npart * 128 + ndk] = nacc;
    __syncthreads();
    if (tid < 128) ((float*)(ws + WS_DN))[(seq * 8 + J) * 128 + tid] = (NR[tid] + NR[128 + tid]) + (NR[256 + tid] + NR[384 + tid]);
    __syncthreads();
}
DI void mfin_unit(const Args& a, LAS unsigned char* lds, int seq) {
    unsigned char* ws = a.ws;
    const int tid = threadIdx.x;
    LAS float* KAP = (LAS float*)(lds + M_KAP);
    const float* ALPHA = (const float*)(ws + WS_ALPHA) + seq * 2048; const float* MTG = (const float*)(ws + WS_MT) + seq * 2048;
    __syncthreads();
    if (tid < 8) { const int ep = 256 * tid + 255; const float Bl = ALPHA[2047] + MTG[2047], Bep = ALPHA[ep] + MTG[ep];
        KAP[tid] = __expf((Bl - Bep) + ((const float*)(ws + WS_MU))[seq * 8 + tid] - MTG[2047]); }
    __syncthreads();
    f32x4 cacc[8];
#pragma unroll
    for (int i = 0; i < 8; ++i) cacc[i] = (f32x4){0.f, 0.f, 0.f, 0.f};
    float nacc = 0.f;
    const float* dc = (const float*)(ws + WS_DC) + (size_t)seq * 8 * 16384 + tid * 4; const float* dn = (const float*)(ws + WS_DN) + seq * 8 * 128;
#pragma unroll 1
    for (int jp = 0; jp < 8; ++jp) { const float f = KAP[jp];
#pragma unroll
        for (int i = 0; i < 8; ++i) cacc[i] = cacc[i] + *(const f32x4*)(dc + (size_t)jp * 16384 + 2048 * i) * f;
        if (tid < 128) nacc += dn[jp * 128 + tid] * f; }
    float* co = a.out + O_CP + (size_t)seq * 16384 + tid * 4;
#pragma unroll
    for (int i = 0; i < 8; ++i) *(f32x4*)(co + 2048 * i) = cacc[i];
    if (tid < 128) a.out[O_NP + seq * 128 + tid] = nacc;
    __syncthreads();
}
constexpr int S_SC = 0, S_VP = 16384, S_Q = 24576, S_RED = 25600, S_OB = 58368, S_IMP = 61440, S_SEL = 62720;
DI void snsa_softmax(LAS float* SC, int n, int wave, int lane) {
    if (wave < 4) { LAS float* sc = SC + wave * 1024; float mx = -INFINITY;
        for (int k = lane; k < n; k += 64) mx = fmaxf(mx, sc[k]);
        mx = wave_max(mx); const float ms = mx == -INFINITY ? 0.f : mx; float sm = 0.f;
        for (int k = lane; k < n; k += 64) { const float p = ex2(sc[k] - ms); sc[k] = p; sm += p; }
        sm = wave_sum(sm); const float inv = sm > 0.f ? 1.f / fmaxf(sm, 1e-30f) : 0.f;
        for (int k = lane; k < n; k += 64) sc[k] *= inv; }
}
DI void snsa_key(const Args& a, int br, int kk, int s, int g, const LAS int* SEL, const int* pt, const float*& kp, const float*& vp, int& dist, bool& valid) {
    valid = true;
    if (br == 1) { const int pos = SEL[kk >> 6] * 64 + (kk & 63); dist = PAST - pos; valid = pos <= PAST;
        if (pos < PAST) { const float* base = INF(a, I_CKV) + ((size_t)pt[pos >> 7] * PAGE + (pos & 127)) * 512; kp = base + 256 + g * 64; vp = base + 384 + g * 64; }
        else { const float* base = a.out + O_KVS + (size_t)s * 512; kp = base + 256 + g * 64; vp = base + 384 + g * 64; } }
    else { const int w = kk + 1; dist = 511 - kk;
        const float* base = w < 512 ? INF(a, I_CWIN) + ((size_t)s * 512 + w) * 256 : a.out + O_WINS + ((size_t)s * 512 + 511) * 256; kp = base + g * 64; vp = base + 128 + g * 64; }
}
DI void snsa_unit(const Args& a, LAS unsigned char* lds, int s, int g) {
    unsigned char* ws = a.ws;
    int tid_ = threadIdx.x; asm volatile("" : "+v"(tid_));
    const int tid = tid_, lane = tid & 63, wave = __builtin_amdgcn_readfirstlane(tid >> 6), ksl = tid >> 4, c16 = tid & 15;
    const size_t row = (size_t)MPR + s;
    LAS float* SC = (LAS float*)(lds + S_SC); LAS unsigned long long* VP = (LAS unsigned long long*)(lds + S_VP); LAS float* Q = (LAS float*)(lds + S_Q); LAS float* RED = (LAS float*)(lds + S_RED);
    LAS float* OBR = (LAS float*)(lds + S_OB); LAS float* IMP = (LAS float*)(lds + S_IMP); LAS int* SEL = (LAS int*)(lds + S_SEL);
    const float* rbias = INF(a, I_RB); const int* pt = (const int*)a.in[I_PT] + s * NPAGES;
    const bf16_t* kcb = (const bf16_t*)(ws + WS_KC) + ((size_t)AROWS_P + (size_t)(s * 2 + g) * 1024) * 64; const bf16_t* vcb = kcb + (size_t)AROWS * 64;
    __syncthreads();
    if (tid < 256) Q[tid] = bf2f(((const bf16_t*)(ws + WS_QA))[row * 512 + g * 256 + tid]);
    __syncthreads();
    f32x4 q4[4];
#pragma unroll
    for (int hq = 0; hq < 4; ++hq) q4[hq] = *(const LAS f32x4*)(Q + hq * 64 + 4 * c16);
    const int myh = 2 * (c16 & 1) + ((c16 >> 1) & 1);
#pragma unroll 1
    for (int br = 0; br < 3; ++br) {
        const int nkeys = br == 0 ? 1023 : (br == 1 ? 1024 : 512);
#pragma unroll 1
        for (int k0 = ksl; k0 < nkeys; k0 += 256) {
            f32x4 x[8]; int dist[8]; bool valid[8];
#pragma unroll
            for (int u = 0; u < 8; ++u) { const int kk = k0 + 32 * u; const int kc = kk < nkeys ? kk : k0;
                if (br == 0) { const u32x2 w = *(const u32x2*)(kcb + (size_t)kc * 64 + 4 * c16); x[u] = (f32x4){bf2f(w.x & 0xffffu), bf2f(w.x >> 16), bf2f(w.y & 0xffffu), bf2f(w.y >> 16)}; dist[u] = 16353 - 16 * kc; valid[u] = true; }
                else { const float* kp; const float* vp; snsa_key(a, br, kc, s, g, SEL, pt, kp, vp, dist[u], valid[u]); x[u] = *(const f32x4*)(kp + 4 * c16); if (c16 == 0 && kk < nkeys) VP[kk] = (unsigned long long)(uintptr_t)vp; } }
#pragma unroll
            for (int u = 0; u < 8; ++u) { const int kk = k0 + 32 * u;
                float p0 = x[u].x * q4[0].x + x[u].y * q4[0].y + x[u].z * q4[0].z + x[u].w * q4[0].w, p1 = x[u].x * q4[1].x + x[u].y * q4[1].y + x[u].z * q4[1].z + x[u].w * q4[1].w;
                float p2 = x[u].x * q4[2].x + x[u].y * q4[2].y + x[u].z * q4[2].z + x[u].w * q4[2].w, p3 = x[u].x * q4[3].x + x[u].y * q4[3].y + x[u].z * q4[3].z + x[u].w * q4[3].w;
                const bool o1 = (c16 & 1) != 0, o2 = (c16 & 2) != 0;
                float ka = o1 ? p2 : p0, kb2 = o1 ? p3 : p1; const float sa = o1 ? p0 : p2, sb = o1 ? p1 : p3;
                ka += __shfl_xor(sa, 1); kb2 += __shfl_xor(sb, 1);
                float e = o2 ? kb2 : ka; const float f = o2 ? ka : kb2;
                e += __shfl_xor(f, 2); e += __shfl_xor(e, 4); e += __shfl_xor(e, 8);
                if (c16 < 4 && kk < nkeys) SC[myh * 1024 + kk] = valid[u] ? e + rbias[rel_bucket(dist[u]) * 8 + g * 4 + myh] * LOG2E : -INFINITY; }
        }
        __syncthreads();
        snsa_softmax(SC, nkeys, wave, lane);
        __syncthreads();
        { f32x4 o[4];
#pragma unroll
          for (int hq = 0; hq < 4; ++hq) o[hq] = (f32x4){0.f, 0.f, 0.f, 0.f};
#pragma unroll 1
          for (int k0 = ksl; k0 < nkeys; k0 += 256) {
              f32x4 v[8];
#pragma unroll
              for (int u = 0; u < 8; ++u) { const int kk = k0 + 32 * u; const int kc = kk < nkeys ? kk : k0;
                  if (br == 0) { const u32x2 w = *(const u32x2*)(vcb + (size_t)kc * 64 + 4 * c16); v[u] = (f32x4){bf2f(w.x & 0xffffu), bf2f(w.x >> 16), bf2f(w.y & 0xffffu), bf2f(w.y >> 16)}; }
                  else v[u] = *(const f32x4*)((const float*)(uintptr_t)VP[kc] + 4 * c16); }
#pragma unroll
              for (int u = 0; u < 8; ++u) { const int kk = k0 + 32 * u; if (kk < nkeys) {
#pragma unroll
                  for (int hq = 0; hq < 4; ++hq) o[hq] = o[hq] + v[u] * SC[hq * 1024 + kk]; } }
          }
#pragma unroll
          for (int hq = 0; hq < 4; ++hq) *(LAS f32x4*)(RED + (ksl * 4 + hq) * 64 + 4 * c16) = o[hq]; }
        if (br == 0) {
            if (tid < 257) { const int j = tid; float im = 0.f; const int i0 = 4 * j - 1 < 0 ? 0 : 4 * j - 1, i1 = 4 * j + 3 > 1022 ? 1022 : 4 * j + 3;
                for (int hq = 0; hq < 4; ++hq) for (int i = i0; i <= i1; ++i) im += SC[hq * 1024 + i];
                IMP[j] = (j == 0 || j >= 255) ? 1e9f : im; }
        }
        __syncthreads();
        if (tid < 256) { float o = 0.f;
#pragma unroll 8
            for (int p32 = 0; p32 < 32; ++p32) o += RED[p32 * 256 + tid]; OBR[br * 256 + tid] = o; }
        if (br == 0 && tid < 257) { const float my = IMP[tid]; int rank = 0;
#pragma unroll 8
            for (int k = 0; k < 257; ++k) { const float o = IMP[k]; rank += (o > my || (o == my && k < tid)) ? 1 : 0; } if (rank < 16) SEL[rank] = tid; }
        __syncthreads();
    }
    if (tid < 256) { const int hq = tid >> 6; const float* ga = (const float*)(ws + WS_GA) + row * 32 + (g * 4 + hq) * 3;
        const float o = ga[0] * OBR[tid] + ga[1] * OBR[256 + tid] + ga[2] * OBR[512 + tid];
        ((bf16_t*)(ws + WS_OAHB))[row * 1024 + g * 256 + tid] = (bf16_t)(pk2(o, 0.f) & 0xffffu); }
    __syncthreads();
}
DI void smlstm_unit(const Args& a, LAS unsigned char* lds, int s, int h) {
    unsigned char* ws = a.ws;
    const int tid = threadIdx.x, lane = tid & 63, dv = tid & 127, part = tid >> 7;
    const size_t row = (size_t)MPR + s; const int sh = s * 4 + h;
    LAS float* QF = (LAS float*)lds; LAS float* KF = QF + 128; LAS float* VF = QF + 256; LAS float* RED = QF + 384; LAS float* HV = QF + 896; LAS float* SCL = QF + 1024;
    const float* C0 = INF(a, I_SC) + (size_t)sh * 16384; const float* n0 = INF(a, I_SN) + sh * 128;
    __syncthreads();
    if (tid < 128) { QF[tid] = bf2f(((const bf16_t*)(ws + WS_QB))[row * 512 + h * 128 + tid]); KF[tid] = bf2f(((const bf16_t*)(ws + WS_KB))[row * 512 + h * 128 + tid]); VF[tid] = bf2f(((const bf16_t*)(ws + WS_VB))[row * 512 + h * 128 + tid]); }
    __syncthreads();
    if (tid < 64) { const float qk = wave_sum(QF[lane] * KF[lane] + QF[lane + 64] * KF[lane + 64]); const float qn = wave_sum(QF[lane] * n0[lane] + QF[lane + 64] * n0[lane + 64]);
        if (lane == 0) { SCL[0] = qk; SCL[1] = qn; } }
    const float* gr = (const float*)(ws + WS_GA) + row * 32; const float ip = gr[24 + h], fp = gr[28 + h], m0 = INF(a, I_SM)[sh];
    const float lf = fminf(fp, 0.f) - log1pf(__expf(-fabsf(fp))), ain = lf + m0, mt = fmaxf(ain, ip), w_in = __expf(ain - mt), wi = __expf(ip - mt);
    __syncthreads();
    float num = 0.f; float* Co = a.out + O_CS + (size_t)sh * 16384; const float vv = VF[dv];
    { float c0v[32];
#pragma unroll
      for (int i = 0; i < 32; ++i) c0v[i] = C0[(size_t)(part * 32 + i) * 128 + dv];
#pragma unroll
      for (int i = 0; i < 32; ++i) { const int dk = part * 32 + i; num += QF[dk] * c0v[i]; Co[(size_t)dk * 128 + dv] = w_in * c0v[i] + wi * KF[dk] * vv; } }
    RED[part * 128 + dv] = num;
    __syncthreads();
    if (tid < 128) { const float nt = (RED[dv] + RED[128 + dv]) + (RED[256 + dv] + RED[384 + dv]); const float sw = SCL[0] * wi; const float den = w_in * SCL[1] + sw;
        HV[dv] = (w_in * nt + sw * vv) / fmaxf(fabsf(den), __expf(-mt));
        a.out[O_NS + sh * 128 + dv] = w_in * n0[dv] + wi * KF[dv];
        if (tid == 0) a.out[O_MS + sh] = mt; }
    __syncthreads();
    if (tid < 128) { float s1 = 0.f; for (int i = 0; i < 128; ++i) s1 += HV[i]; const float mu = s1 * (1.f / 128.f); float s2 = 0.f; for (int i = 0; i < 128; ++i) { const float dl = HV[i] - mu; s2 += dl * dl; }
        const float rstd = 1.f / sqrtf(s2 * (1.f / 128.f) + EPS);
        const float o = (HV[dv] - mu) * rstd * INF(a, I_GNORM)[h * 128 + dv] * bf2f(((const bf16_t*)(ws + WS_OB))[row * 512 + h * 128 + dv]);
        ((bf16_t*)(ws + WS_OAHB))[row * 1024 + 512 + h * 128 + dv] = (bf16_t)(pk2(o, 0.f) & 0xffffu); }
    __syncthreads();
}

constexpr int NU_TOTAL = 992;
#ifndef DUP_MASK
#define DUP_MASK 0
#endif
#ifndef P4F_A
#define P4F_A 1
#endif
#ifndef P4F_B
#define P4F_B 1
#endif
#ifndef P4F_C
#define P4F_C 1
#endif
DI void p4_run(const Args& a, LAS unsigned char* lds, unsigned* qctr, const XcdBarrier& fb, unsigned* F, unsigned* F2, unsigned* F4a, unsigned* F4b) {
    const int tid = threadIdx.x, lane = tid & 63, wave = __builtin_amdgcn_readfirstlane(tid >> 6);
    LAS int* UQ = (LAS int*)(lds + RING_BYTES + 64);
    int u;
#define NEXT_UNIT4() do { __syncthreads(); if (tid == 0) *UQ = (int)__hip_atomic_fetch_add(qctr, 1u, __ATOMIC_RELAXED, __HIP_MEMORY_SCOPE_AGENT); __syncthreads(); u = __builtin_amdgcn_readfirstlane(*UQ); } while (0)
    if (tid == 0) *(volatile LAS int*)(lds + RING_BYTES + 192) = 0;
    if (F2 != nullptr) xcd_flag_wait(fb, F2);
    NEXT_UNIT4();
    constexpr int CS = 32, C0 = CS + 128 * P4F_A, C1 = C0 + 256 * P4F_B, C2 = C1, C3 = C2 + 256 * P4F_C;
#pragma unroll 1
    while (u < CS) { if (wave == 0) scan_unit(a, u, lane); NEXT_UNIT4(); }
#pragma unroll 1
    while (u < C0) { const int v = (u - CS) % 128; pcmp_unit(a, lds, v >> 6, (v >> 2) & 15, v & 3, wave, lane); NEXT_UNIT4(); }
#pragma unroll 1
    while (u < C1) { const int v = (u - C0) % 256; mblk_unit(a, lds, v >> 5, (v >> 3) & 3, v & 7); NEXT_UNIT4(); }
    if (F4a != nullptr) xcd_flag_arrive(fb, F4a);
    if (F != nullptr && u < C3) { w2_stage(a, lds, tid); xcd_flag_wait(fb, F); }
#pragma unroll 1
    while (u < C3) { const int v = (u - C2) % 256; w2_unit(a, lds, v, wave, lane); NEXT_UNIT4(); }
    if (F4b != nullptr) xcd_flag_arrive(fb, F4b);
#undef NEXT_UNIT4
}
DI void p5_run(const Args& a, LAS unsigned char* lds, unsigned* qctr, const XcdBarrier& fb, unsigned* F4a, unsigned* F4b) {
    const int tid = threadIdx.x;
    if (F4a != nullptr) xcd_flag_wait(fb, F4a);
        LAS int* UQ = (LAS int*)(lds + RING_BYTES + 64);
        int u;
#ifndef UNIT_MASK
#define UNIT_MASK 31
#endif
#define NEXT_UNIT() do { __syncthreads(); if (tid == 0) *UQ = (int)__hip_atomic_fetch_add(qctr, 1u, __ATOMIC_RELAXED, __HIP_MEMORY_SCOPE_AGENT); __syncthreads(); u = __builtin_amdgcn_readfirstlane(*UQ); } while (0)
        if (tid == 0) { ((volatile LAS int*)(lds + RING_BYTES + 128))[0] = 0; ((volatile LAS int*)(lds + RING_BYTES + 128))[1] = 0; }
        NEXT_UNIT();
#ifndef F_ST
#define F_ST 1
#endif
#ifndef F_ML
#define F_ML 1
#endif
#ifndef F_NSA
#define F_NSA 1
#endif
#ifndef F_SN
#define F_SN 1
#endif
#ifndef F_SM
#define F_SM 1
#endif
        constexpr int B0 = 64 * F_SN, B1 = B0 + 32 * F_ST, B2 = B1 + 512 * F_NSA, B3 = B2 + 256 * F_ML, B4 = B3 + 128 * F_SM;
        if (F4b != nullptr && u < B0) xcd_flag_wait(fb, F4b);
#pragma unroll 1
        while (u < B0) { const int v = u % 64; snsa_unit(a, lds, v >> 1, v & 1); NEXT_UNIT(); }
#pragma unroll 1
        while (u < B1) { const int v = (u - B0) % 32; mfin_unit(a, lds, v); NEXT_UNIT(); }
#pragma unroll 1
        while (u < B2) { const int v = (u - B1) % 512; nsa_unit(a, lds, (v & 15) >> 1, v & 1, 31 - (v >> 4)); NEXT_UNIT(); }
#pragma unroll 1
        while (u < B3) { const int v = (u - B2) % 256; mlstm_unit(a, lds, (v & 31) >> 2, v & 3, 7 - (v >> 5)); NEXT_UNIT(); }
#pragma unroll 1
        while (u < B4) { const int v = (u - B3) % 128; smlstm_unit(a, lds, v >> 2, v & 3); NEXT_UNIT(); }
#undef NEXT_UNIT
}
constexpr int NPH = 12;
__global__ void __launch_bounds__(NWAVES * 64, 2) fwd(Args a) {
    extern __shared__ __attribute__((aligned(16))) unsigned char lds_raw[];
    LAS unsigned char* lds = (LAS unsigned char*)lds_raw;
    const int tid = threadIdx.x, lane = tid & 63, wave = __builtin_amdgcn_readfirstlane(tid >> 6);
    const int G = gridDim.x; const int bx = blockIdx.x; const int vcu = (G % 8 == 0) ? (bx % 8) * (G / 8) + bx / 8 : bx;
    const int gw = vcu * NWAVES + wave, NGW = G * NWAVES;
    unsigned char* ws = a.ws;
    unsigned* ctl = (unsigned*)(ws + WS_CTL);
    volatile LAS unsigned* MISC = (volatile LAS unsigned*)(lds + MISC_OFF);
    for (int u = tid; u < (LDS_BYTES - RING_BYTES) / 4; u += NWAVES * 64) ((LAS unsigned*)(lds + RING_BYTES))[u] = 0u;
    __syncthreads();
    const int lo = a.ph_lo & 255, hi = a.ph_hi, qsel = a.ph_lo >> 8;
    const bool use_bar = (hi - lo) > 1;
    XcdBarrier bar; bar.bar = ctl + CW_BAR; bar.x = 0; bar.st = nullptr;
    if (use_bar) bar = xcd_barrier_post(ctl + CW_BAR, MISC + 8);
#ifndef PH_MASK
#define PH_MASK 0xFFF
#endif
#define IN(k) ((((PH_MASK) >> (k)) & 1) && lo <= (k) && (k) < hi)
#define SEAM(k) do { if (IN(k) && IN((k) + 1)) { if ((k) == 0) xcd_barrier(bar); else { xcd_flag_arrive(bar, ctl + CW_SEAMF + 4096 * (k)); xcd_flag_wait(bar, ctl + CW_SEAMF + 4096 * (k)); } } } while (0)
#ifndef DUP_MASK
#define DUP_MASK 0
#endif
#ifndef DUPB_MASK
#define DUPB_MASK 0
#endif
#define REP(k) _Pragma("unroll 1") for (int rep = 0; rep < 1 + ((((DUP_MASK) | (DUPB_MASK)) >> (k)) & 1); ++rep)
#define REPB(k) do { if ((((DUPB_MASK) >> (k)) & 1) && rep == 0) xcd_barrier(bar); } while (0)

#ifndef XBAR
#define XBAR 0
#endif
    if (IN(0)) { REP(0) { p0_prologue(a, lds, gw, NGW, wave, lane); REPB(0); } } SEAM(0);
    if (use_bar) { _Pragma("unroll 1") for (int xb = 0; xb < XBAR; ++xb) xcd_barrier(bar); }
    if (IN(1)) { REP(1) { norm_phase_bf16(a, 0, gw, NGW, lane); late_transposes<2>(a, lds, NGW - 1 - gw, NGW, wave, lane); REPB(1); } } SEAM(1);
    if (IN(2)) { REP(2) {
        pg8::Gemm g{(const bf16_t*)(ws + WS_U), (const bf16_t*)(ws + WS_WIN_T), MPR, NZ, 1024, 1024}; pg8::StaticOrder S; S.init(MPR, NZ, G, bx);
        EpiZ E{(bf16_t*)(ws + WS_QA), (bf16_t*)(ws + WS_KVB), (bf16_t*)(ws + WS_QB), (bf16_t*)(ws + WS_KB), (bf16_t*)(ws + WS_VB), (bf16_t*)(ws + WS_OB), (bf16_t*)(ws + WS_GM), (bf16_t*)(ws + WS_ABF), (float*)(ws + WS_GA), a.out, INF(a, I_GATEB)};
        pg8::gemm_phase<EpiZ>(lds, g, S, E);
        skinny_phase<EpiZ>(lds, g.A, 1024, g.Bt, 1024, NZ, S.nwg, E, bx, G, wave, lane);
        { const int rem_ = S.nwg % G, nl_ = rem_ ? G - rem_ : G, me_ = G - 1 - bx; if (me_ < nl_) { late_transposes<0>(a, lds, me_ * NWAVES + wave, nl_ * NWAVES, wave, lane); if (me_ >= nl_ - 8) cbias_task(a, lds, nl_ - 1 - me_, wave, lane); } }
        REPB(2); }
    }
    const bool p234 = use_bar && IN(2) && IN(3) && IN(4);
    if (p234) xcd_flag_arrive(bar, ctl + CW_FLAG2); else SEAM(2);
    if (IN(3)) { REP(3) {
            pg8::CacheGemm g{INF(a, I_CKV), (const int*)a.in[I_PT], (const bf16_t*)(ws + WS_W1P_T), 0}; pg8::StaticOrder S; S.init(2 * AROWS_S, 1024, G, bx);
            EpiHid E{(bf16_t*)(ws + WS_GH), (bf16_t*)(ws + WS_GH) + (size_t)2 * AROWS_S * 256};
            pg8::gemm_phase_cache<EpiHid>(lds, g, S, E);
            REPB(3);
        }
    }
    const bool p45 = use_bar && IN(4) && IN(5) && DUP_MASK == 0 && DUPB_MASK == 0;
    const bool p34 = use_bar && IN(3) && IN(4);
    if (p34) xcd_flag_arrive(bar, ctl + CW_FLAG); else SEAM(3);
    if (IN(4)) { REP(4) { p4_run(a, lds, ctl + CW_QUEUE + 128 + 64 * (rep + qsel), bar, p34 ? ctl + CW_FLAG : nullptr, p234 ? ctl + CW_FLAG2 : nullptr, p45 ? ctl + CW_SEAMF + 4096 * 11 : nullptr, p45 ? ctl + CW_SEAMF + 4096 * 12 : nullptr); REPB(4); } }
    if (!p45) SEAM(4);
    if (IN(5)) { p5_run(a, lds, ctl + CW_QUEUE + 64 * qsel, bar, p45 ? ctl + CW_SEAMF + 4096 * 11 : nullptr, p45 ? ctl + CW_SEAMF + 4096 * 12 : nullptr); if ((DUPB_MASK >> 5) & 1) { xcd_barrier(bar); p5_run(a, lds, ctl + CW_QUEUE + 64, bar, nullptr, nullptr); } } SEAM(5);
    if (IN(6)) { REP(6) {
        pg8::Gemm g{(const bf16_t*)(ws + WS_OAHB), (const bf16_t*)(ws + WS_WBR_T), MPR, 1024, 1024, 1024}; pg8::StaticOrder S; S.init(MPR, 1024, G, bx);
        EpiBr E{(const bf16_t*)(ws + WS_GM), (bf16_t*)(ws + WS_MIX)};
        pg8::gemm_phase<EpiBr>(lds, g, S, E);
        skinny_phase<EpiBr>(lds, g.A, 1024, g.Bt, 1024, 1024, S.nwg, E, bx, G, wave, lane); }
    } SEAM(6);
    if (IN(7)) { REP(7) {
        pg8::Gemm g{(const bf16_t*)(ws + WS_MIX), (const bf16_t*)(ws + WS_WOUT_T), MPR, 1024, 1024, 1024}; pg8::StaticOrder S; S.init(MPR, 1024, G, bx);
        EpiRes E{INF(a, I_XP), INF(a, I_XS), (bf16_t*)(ws + WS_X1), (const float*)(ws + WS_MOD), 2 * 1024, nullptr};
        pg8::gemm_phase<EpiRes>(lds, g, S, E);
        skinny_phase<EpiRes>(lds, g.A, 1024, g.Bt, 1024, 1024, S.nwg, E, bx, G, wave, lane); }
    } SEAM(7);
    if (IN(8)) { REP(8) { norm_phase_bf16(a, 1, gw, NGW, lane); REPB(8); } } SEAM(8);
    if (IN(9)) { REP(9) {
        pg8::Gemm g{(const bf16_t*)(ws + WS_U), (const bf16_t*)(ws + WS_WFI_T), MPR, NFF, 1024, 1024}; pg8::StaticOrder S; S.init(MPR, NFF, G, bx);
        EpiSwiGLU E{(bf16_t*)(ws + WS_H)};
        pg8::gemm_phase<EpiSwiGLU>(lds, g, S, E);
        skinny_phase<EpiSwiGLU>(lds, g.A, 1024, g.Bt, 1024, NFF, S.nwg, E, bx, G, wave, lane);
        { const int rem_ = S.nwg % G, nl_ = rem_ ? G - rem_ : G, me_ = G - 1 - bx; if (me_ < nl_) { win_copy(a, me_ * NWAVES + wave, nl_ * NWAVES, lane); late_transposes<1>(a, lds, me_ * NWAVES + wave, nl_ * NWAVES, wave, lane); } }
        REPB(9); }
    } SEAM(9);
    if (IN(10)) { REP(10) {
        pg8::Gemm g{(const bf16_t*)(ws + WS_H), (const bf16_t*)(ws + WS_WFO_T), MPR, 1024, FFH, FFH}; pg8::StaticOrder S; S.init(MPR, 1024, G, bx);
        EpiRes E{INF(a, I_XP), INF(a, I_XS), (bf16_t*)(ws + WS_X2), (const float*)(ws + WS_MOD), 5 * 1024, (const bf16_t*)(ws + WS_X1)};
        pg8::gemm_phase<EpiRes>(lds, g, S, E);
        skinny_phase<EpiRes>(lds, g.A, FFH, g.Bt, FFH, 1024, S.nwg, E, bx, G, wave, lane); REPB(10); }
    } SEAM(10);
    if (IN(11)) { REP(11) { final_norm_phase(a, gw, NGW, lane); REPB(11); } }
#undef IN
#undef SEAM
}

#ifndef MK_SPLIT
#define MK_SPLIT 0
#endif
extern "C" void kernel_launch(void* const* d_in, const int* in_sizes, int n_in, void* d_out, int out_size, void* d_ws, size_t ws_size, hipStream_t stream) {
    static int grid = 0;
    if (grid == 0) {
        if (n_in != N_INPUTS || (size_t)out_size != O_END || ws_size < WS_END) { fprintf(stderr, "kernel_launch: unexpected shapes: n_in %d out %d ws %zu (need %zu)\n", n_in, out_size, ws_size, (size_t)WS_END); grid = -1; return; }
        int dev = 0, cus = 0, per_cu = 0;
        if (hipGetDevice(&dev) != hipSuccess || hipDeviceGetAttribute(&cus, hipDeviceAttributeMultiprocessorCount, dev) != hipSuccess) { grid = -1; return; }
        if (hipFuncSetAttribute((const void*)fwd, hipFuncAttributeMaxDynamicSharedMemorySize, LDS_BYTES) != hipSuccess) { fprintf(stderr, "kernel_launch: hipFuncSetAttribute failed\n"); grid = -1; return; }
        if (hipOccupancyMaxActiveBlocksPerMultiprocessor(&per_cu, (const void*)fwd, NWAVES * 64, LDS_BYTES) != hipSuccess || per_cu < 1) fprintf(stderr, "kernel_launch: occupancy query reports %d\n", per_cu);
        (void)hipGetLastError();
        grid = cus;
    }
    if (grid < 0) return;
    if (hipMemsetAsync((char*)d_ws + WS_CTL, 0, CTL_ZERO_BYTES, stream) != hipSuccess) return;
    Args a{};
    for (int i = 0; i < N_INPUTS; ++i) a.in[i] = d_in[i];
    a.out = (float*)d_out; a.ws = (unsigned char*)d_ws;
#if MK_SPLIT
#ifndef DUPKM
#define DUPKM 0
#endif
    for (int p = 0; p < NPH; ++p) { a.ph_lo = p; a.ph_hi = p + 1; for (int rep = 0; rep < (((DUPKM >> p) & 1) ? 2 : 1); ++rep) { a.ph_lo = p | (rep << 8); hipLaunchKernelGGL(fwd, dim3(grid), dim3(NWAVES * 64), LDS_BYTES, stream, a); } }
#else
    a.ph_lo = 0; a.ph_hi = NPH; hipLaunchKernelGGL(fwd, dim3(grid), dim3(NWAVES * 64), LDS_BYTES, stream, a);
#endif
    const hipError_t le = hipPeekAtLastError();
    if (le != hipSuccess) fprintf(stderr, "kernel_launch: launch failed: %s\n", hipGetErrorName(le));
}
```

```cpp
#include <hip/hip_runtime.h>
#include <cstdio>
#include <cstdint>

#define LAS __attribute__((address_space(3)))
#define GAS __attribute__((address_space(1)))
#define DI __device__ __forceinline__
typedef unsigned short bf16_t;
typedef short bf16x8 __attribute__((ext_vector_type(8)));
typedef short s16x4 __attribute__((ext_vector_type(4)));
typedef short v4i16_t __attribute__((ext_vector_type(4)));
typedef float f32x4 __attribute__((ext_vector_type(4)));
typedef float f32x2 __attribute__((ext_vector_type(2)));
typedef float f32x16 __attribute__((ext_vector_type(16)));
typedef unsigned u32x4 __attribute__((ext_vector_type(4)));
typedef unsigned u32x2 __attribute__((ext_vector_type(2)));
typedef __bf16 bf16x2_t __attribute__((ext_vector_type(2)));

DI float bf2f(unsigned v) { return __builtin_bit_cast(float, v << 16); }
DI unsigned pk2(float lo, float hi) { f32x2 v = {lo, hi}; bf16x2_t b = __builtin_convertvector(v, bf16x2_t); return __builtin_bit_cast(unsigned, b); }
DI float sigmoidf_(float x) { return __builtin_amdgcn_rcpf(1.f + __builtin_amdgcn_exp2f(x * -1.4426950408889634f)); }
DI float wave_sum(float v) {
#pragma unroll
    for (int o = 1; o < 64; o <<= 1) v += __shfl_xor(v, o);
    return v;
}
DI float wave_max(float v) {
#pragma unroll
    for (int o = 1; o < 64; o <<= 1) v = fmaxf(v, __shfl_xor(v, o));
    return v;
}

constexpr int D = 1024, NBATCH = 8, T = 2048, MPR = NBATCH * T, NSMP = 32, MREAL = MPR + NSMP, MP = 16640;
constexpr int NIN = 5408, NZ = 5632, FFH = 2816, NFF = 2 * FFH;
constexpr int PAST = 16384, NPAGES = 128, PAGE = 128;
constexpr int AROWS_P = 2048, AROWS_S = 65536, AROWS = AROWS_P + AROWS_S;
constexpr float LOG2E = 1.4426950408889634f;
constexpr float QSCALE = 0.125f * LOG2E;
constexpr float EPS = 1e-6f;

constexpr size_t O_Y = 0, O_YS = 16777216, O_KVP = 16809984, O_KVS = 25198592, O_WINP = 25214976, O_WINS = 26263552, O_CP = 30457856, O_NP = 30982144, O_MP = 30986240,
                 O_CS = 30986272, O_NS = 33083424, O_MS = 33099808, O_END = 33099936;

constexpr size_t al256(size_t x) { return (x + 255) & ~(size_t)255; }
constexpr size_t WS_CTL = 0, CTL_ZERO_BYTES = 1u << 20;
constexpr size_t WS_WIN_T = CTL_ZERO_BYTES;
constexpr size_t WS_WBR_T = WS_WIN_T + (size_t)NZ * 1024 * 2;
constexpr size_t WS_WOUT_T = WS_WBR_T + (size_t)1024 * 1024 * 2;
constexpr size_t WS_WFI_T = WS_WOUT_T + (size_t)1024 * 1024 * 2;
constexpr size_t WS_WFO_T = WS_WFI_T + (size_t)NFF * 1024 * 2;
constexpr size_t WS_W1C_T = WS_WFO_T + (size_t)1024 * FFH * 2;
constexpr size_t WS_W1P_T = WS_W1C_T + (size_t)2 * 256 * 2048 * 2;
constexpr size_t WS_W2C_T = WS_W1P_T + (size_t)2 * 512 * 1024 * 2;
constexpr size_t WS_MOD = WS_W2C_T + (size_t)2 * 64 * 256 * 2;
constexpr size_t WS_MODF = WS_MOD + (size_t)40 * 6144 * 4;
constexpr size_t WS_CBIAS = WS_MODF + (size_t)40 * 2048 * 4;
constexpr size_t WS_U = al256(WS_CBIAS + 2 * 256 * 4);
constexpr size_t WS_QA = WS_U + (size_t)MP * 1024 * 2;
constexpr size_t WS_KVB = WS_QA + (size_t)MP * 512 * 2;
constexpr size_t WS_QB = WS_KVB + (size_t)MP * 512 * 2;
constexpr size_t WS_KB = WS_QB + (size_t)MP * 512 * 2;
constexpr size_t WS_VB = WS_KB + (size_t)MP * 512 * 2;
constexpr size_t WS_OB = WS_VB + (size_t)MP * 512 * 2;
constexpr size_t WS_GM = WS_OB + (size_t)MP * 512 * 2;
constexpr size_t WS_GA = WS_GM + (size_t)MP * 2048 * 2;
constexpr size_t ABF_KIND = ((size_t)AROWS * 1024 + 4096) * 2;
constexpr size_t WS_ABF = WS_GA + (size_t)MP * 32 * 4;
constexpr size_t WS_GH = WS_ABF + 2 * ABF_KIND;
constexpr size_t WS_KC = WS_GH + (size_t)2 * AROWS_S * 512 * 2 + 4096;
constexpr size_t WS_ALPHA = WS_KC + (size_t)2 * AROWS * 64 * 2;
constexpr size_t WS_BETA = WS_ALPHA + 32 * 2048 * 4;
constexpr size_t WS_MT = WS_BETA + 32 * 2048 * 4;
constexpr size_t WS_OAHB = WS_MT + 32 * 2048 * 4;
constexpr size_t WS_MIX = WS_OAHB + (size_t)MP * 1024 * 2;
constexpr size_t WS_X1 = WS_MIX + (size_t)MP * 1024 * 2;
constexpr size_t WS_H = WS_X1 + (size_t)MP * 1024 * 4;
constexpr size_t WS_X2 = WS_H + (size_t)MP * FFH * 2;
constexpr size_t WS_NSCR = WS_X2 + (size_t)MP * 1024 * 4;
constexpr size_t WS_DC = WS_NSCR + (size_t)256 * 8 * 32 * 64 * 4;
constexpr size_t WS_DN = WS_DC + (size_t)32 * 8 * 16384 * 4;
constexpr size_t WS_MU = WS_DN + (size_t)32 * 8 * 128 * 4;
constexpr size_t WS_END = WS_MU + 4096;

constexpr int CW_QUEUE = 64;
constexpr int CW_BAR = 4096;
constexpr int CW_FLAG = 8192;
constexpr int CW_FLAG2 = 12288;
constexpr int CW_SEAMF = 16384;

namespace pg8 {
constexpr int BM = 256, BK = 64, HALF = 128, HTB = HALF * BK * 2, STAGE_BYTES = 8 * HTB, NXCD = 8, WGM = 8;
__host__ __device__ __forceinline__ int lds_byte(int r, int c) { const int st = (r >> 4) * 2 + (c >> 5), rr = r & 15, cc = c & 31, ob = rr * 64 + cc * 2; return st * 1024 + (ob ^ (((ob >> 9) & 1) << 5)); }
__host__ __device__ __forceinline__ void stage_rc(int b, int& R, int& C) { const int st = b / 1024, sb = b % 1024, swz = sb ^ (((sb >> 9) & 1) << 5); R = (st >> 1) * 16 + swz / 64; C = (st & 1) * 32 + (swz % 64) / 2; }
__host__ __device__ __forceinline__ int perm32(int rho) { const int n = rho >> 4, i = rho & 15; return 8 * (i >> 2) + 4 * n + (i & 3); }
struct Unit { int pm, pn; };
struct Gemm { const bf16_t* A; const bf16_t* Bt; int M, N, K, lda; };
struct StaticOrder {
    int nM, nN, nwg, G, c;
    __host__ __device__ void init(int M, int N, int G_, int c_) { nM = M / BM; nN = N / BM; nwg = nM * nN; G = G_; c = c_; }
    __host__ __device__ bool next(int i, Unit& u) const {
        const long L = (long)i * G + c; if (L >= nwg) return false;
        int wgid = (int)L; { const int q = nwg / NXCD, r = nwg % NXCD, xcd = wgid % NXCD, off = wgid / NXCD; wgid = (xcd < r ? xcd * (q + 1) : r * (q + 1) + (xcd - r) * q) + off; }
        const int nig = WGM * nN, gid = wgid / nig, fm = gid * WGM, gsz = (nM - fm) < WGM ? (nM - fm) : WGM;
        u.pm = fm + ((wgid % nig) % gsz); u.pn = (wgid % nig) / gsz; return true;
    }
};
template <class Epi>
__device__ __forceinline__ void gemm_phase(LAS unsigned char* lds, const Gemm g, const StaticOrder& S, const Epi& E) {
    const int tid = threadIdx.x, wid = __builtin_amdgcn_readfirstlane(tid >> 6), lane = tid & 63, wr = wid >> 2, wc = wid & 3, fr = lane & 15, fq = lane >> 4;
    const int K = g.K, nt = K / BK, lda = g.lda;
    unsigned voffA[2], voffB[2];
#pragma unroll
    for (int i = 0; i < 2; ++i) { int R, C; stage_rc(tid * 16 + i * 8192, R, C); const int Rb = (R & ~31) + perm32(R & 31);
        voffA[i] = (unsigned)(R * lda + C) * 2u; voffB[i] = (unsigned)(Rb * K + C) * 2u; }
    const size_t kstep = (size_t)(BK * 2);
    const size_t hstepA = (size_t)HALF * lda * 2, hstepB = (size_t)HALF * K * 2;
    const size_t tstepA = 2 * hstepA, tstepB = 2 * hstepB;
    const unsigned ldsw = (unsigned)wid * 1024u;
    const int aoff = lds_byte(wr * 64 + fr, fq * 8), boff = lds_byte(wc * 32 + fr, fq * 8);
#define PG8_SA(b, h) (((b) * 2 + (h)) * HTB)
#define PG8_SB(b, h) ((4 + (b) * 2 + (h)) * HTB)
#define PG8_STAGE(bufoff, gbase, voff) do { _Pragma("unroll") for (int _i = 0; _i < 2; ++_i) \
        __builtin_amdgcn_global_load_lds((const unsigned*)((const char*)(gbase) + (voff)[_i]), (LAS unsigned*)(lds + (bufoff) + ldsw + _i * 8192), 16, 0, 0); } while (0)
#define PG8_LDA(dst, b, h) do { _Pragma("unroll") for (int m = 0; m < 4; ++m) _Pragma("unroll") for (int k = 0; k < 2; ++k) dst[m][k] = *(const LAS bf16x8*)(lds + PG8_SA(b, h) + aoff + m * 2048 + k * 1024); } while (0)
#define PG8_LDB(dst, b, h) do { _Pragma("unroll") for (int n = 0; n < 2; ++n) _Pragma("unroll") for (int k = 0; k < 2; ++k) dst[n][k] = *(const LAS bf16x8*)(lds + PG8_SB(b, h) + boff + n * 2048 + k * 1024); } while (0)
#define PG8_MMA(ai, bj, At, Bt) do { __builtin_amdgcn_s_setprio(1); _Pragma("unroll") for (int m = 0; m < 4; ++m) _Pragma("unroll") for (int n = 0; n < 2; ++n) _Pragma("unroll") for (int k = 0; k < 2; ++k) \
        acc[ai][bj][m][n] = __builtin_amdgcn_mfma_f32_16x16x32_bf16(Bt[n][k], At[m][k], acc[ai][bj][m][n], 0, 0, 0); __builtin_amdgcn_s_setprio(0); } while (0)
#define PG8_WAIT_V(n) asm volatile("s_waitcnt vmcnt(" #n ")" ::: "memory")
#define PG8_WAIT_L(n) asm volatile("s_waitcnt lgkmcnt(" #n ")" ::: "memory")
#define PG8_BAR __builtin_amdgcn_s_barrier()
#define PG8_SCHED __builtin_amdgcn_sched_barrier(0)
    Unit cur, nxt; int ui = 0;
    if (!S.next(0, cur)) return;
    f32x4 acc[2][2][4][2];
#pragma unroll
    for (int a = 0; a < 2; ++a)
#pragma unroll
        for (int b = 0; b < 2; ++b)
#pragma unroll
            for (int m = 0; m < 4; ++m)
#pragma unroll
                for (int n = 0; n < 2; ++n) acc[a][b][m][n] = (f32x4){0.f, 0.f, 0.f, 0.f};
    bf16x8 At[4][2], B0[2][2], B1[2][2];
    const char* cA = (const char*)g.A + (size_t)cur.pm * tstepA; const char* cB = (const char*)g.Bt + (size_t)cur.pn * tstepB;
    PG8_STAGE(PG8_SB(0, 0), cB, voffB); PG8_STAGE(PG8_SB(0, 1), cB + hstepB, voffB); PG8_STAGE(PG8_SA(0, 0), cA, voffA); PG8_STAGE(PG8_SA(0, 1), cA + hstepA, voffA);
    if (wr == 1) PG8_BAR;
    PG8_WAIT_V(2); PG8_BAR;
    PG8_STAGE(PG8_SB(1, 0), cB + kstep, voffB); PG8_STAGE(PG8_SA(1, 0), cA + kstep, voffA); PG8_STAGE(PG8_SB(1, 1), cB + hstepB + kstep, voffB);
    PG8_WAIT_V(6); PG8_BAR;
    for (;;) {
        const bool has_next = S.next(ui + 1, nxt);
        const char* nA = has_next ? (const char*)g.A + (size_t)nxt.pm * tstepA : cA; const char* nB = has_next ? (const char*)g.Bt + (size_t)nxt.pn * tstepB : cB;
        for (int t = 0; t < nt; t += 2) {
            const bool last = (t == nt - 2);
            const char* a1 = cA + (size_t)(t + 1) * kstep;
            const char* a2 = last ? nA : cA + (size_t)(t + 2) * kstep; const char* b2 = last ? nB : cB + (size_t)(t + 2) * kstep;
            const char* a3 = a2 + kstep; const char* b3 = b2 + kstep;
            if constexpr (Epi::HAS_MID) { if (t == Epi::MID_T) E.mid(acc, cur, wr, wc, fr, fq); }
            PG8_LDB(B0, 0, 0); PG8_LDB(B1, 0, 1); PG8_SCHED; PG8_LDA(At, 0, 0); PG8_STAGE(PG8_SA(1, 1), a1 + hstepA, voffA);
            PG8_WAIT_V(8); PG8_WAIT_L(0); PG8_BAR; PG8_MMA(0, 0, At, B0); PG8_MMA(0, 1, At, B1); PG8_BAR; PG8_SCHED;
            PG8_LDA(At, 0, 1); PG8_STAGE(PG8_SB(0, 0), b2, voffB); PG8_STAGE(PG8_SB(0, 1), b2 + hstepB, voffB); PG8_STAGE(PG8_SA(0, 0), a2, voffA);
            PG8_WAIT_V(8); PG8_WAIT_L(0); PG8_BAR; PG8_MMA(1, 0, At, B0); PG8_MMA(1, 1, At, B1); PG8_BAR; PG8_SCHED;
            PG8_LDB(B0, 1, 0); PG8_LDB(B1, 1, 1); PG8_SCHED; PG8_LDA(At, 1, 0); PG8_STAGE(PG8_SA(0, 1), a2 + hstepA, voffA);
            PG8_WAIT_V(8); PG8_WAIT_L(0); PG8_BAR; PG8_MMA(0, 0, At, B0); PG8_MMA(0, 1, At, B1); PG8_BAR; PG8_SCHED;
            PG8_LDA(At, 1, 1); PG8_STAGE(PG8_SB(1, 0), b3, voffB); PG8_STAGE(PG8_SB(1, 1), b3 + hstepB, voffB); PG8_STAGE(PG8_SA(1, 0), a3, voffA);
            PG8_WAIT_V(8); PG8_WAIT_L(0); PG8_BAR; PG8_MMA(1, 0, At, B0); PG8_MMA(1, 1, At, B1); PG8_BAR; PG8_SCHED;
        }
        if (wr == 0) PG8_BAR;
        {
            const int rbase = cur.pm * BM + wr * 64 + fr, cbase = cur.pn * BM + wc * 32 + 8 * fq;
#pragma unroll
            for (int ai = 0; ai < 2; ++ai)
#pragma unroll
                for (int m = 0; m < 4; ++m)
#pragma unroll
                    for (int bj = 0; bj < 2; ++bj) E.elem(rbase + ai * HALF + m * 16, cbase + bj * HALF, acc[ai][bj][m][0], acc[ai][bj][m][1]);
        }
        if (!has_next) break;
#pragma unroll
        for (int a = 0; a < 2; ++a)
#pragma unroll
            for (int b = 0; b < 2; ++b)
#pragma unroll
                for (int m = 0; m < 4; ++m)
#pragma unroll
                    for (int n = 0; n < 2; ++n) acc[a][b][m][n] = (f32x4){0.f, 0.f, 0.f, 0.f};
        cur = nxt; cA = nA; cB = nB; ++ui;
        if (wr == 1) PG8_BAR;
    }
    PG8_WAIT_V(0);
    PG8_BAR;
#undef PG8_SA
#undef PG8_SB
#undef PG8_STAGE
#undef PG8_LDA
#undef PG8_LDB
#undef PG8_MMA
#undef PG8_WAIT_V
#undef PG8_WAIT_L
#undef PG8_BAR
#undef PG8_SCHED
}
struct CacheGemm { const float* cache; const int* pt; const bf16_t* Bt; int kind; };
template <class Epi>
__device__ __forceinline__ void gemm_phase_cache(LAS unsigned char* lds, const CacheGemm g, const StaticOrder& S, const Epi& E) {
    const int tid = threadIdx.x, wid = __builtin_amdgcn_readfirstlane(tid >> 6), lane = tid & 63, wr = wid >> 2, wc = wid & 3, fr = lane & 15, fq = lane >> 4;
    constexpr int K = 1024;
    unsigned voffB[2];
#pragma unroll
    for (int i = 0; i < 2; ++i) { int R, C; stage_rc(tid * 16 + i * 8192, R, C); const int Rb = (R & ~31) + perm32(R & 31); voffB[i] = (unsigned)(Rb * K + C) * 2u; }
    const size_t kstepB = (size_t)(BK * 2), hstepB = (size_t)HALF * K * 2, tstepB = 2 * hstepB;
    const unsigned ldsw = (unsigned)wid * 1024u;
    const int aoff = lds_byte(wr * 64 + fr, fq * 8), boff = lds_byte(wc * 32 + fr, fq * 8);
    const unsigned laneoff = (unsigned)((lane >> 5) * 32768 + (lane & 31) * 16);
    const unsigned lo0 = laneoff, lo1 = laneoff + 65536u, lo2 = laneoff + 131072u, lo3 = laneoff + 196608u;
    const int awoff = lds_byte(((lane >> 4) & 1) * 64 + wid * 8 + (lane >> 5), 4 * (lane & 15));
    const char* cacheb = (const char*)g.cache;
#define PG8_STAGEB(sbo_, h, gbase) do { _Pragma("unroll") for (int _i = 0; _i < 2; ++_i) \
        __builtin_amdgcn_global_load_lds((const unsigned*)((const char*)(gbase) + voffB[_i]), (LAS unsigned*)(lds + (sbo_) + (h) * HTB + ldsw + _i * 8192), 16, 0, 0); } while (0)
#define PG8_LDR(dst, ub, tile) do { const char* sb_ = cacheb + (ub) + (size_t)((tile) * 2048); \
        asm volatile("global_load_dwordx4 %0, %1, %2" : "=v"(dst[0]) : "v"(lo0), "s"(sb_) : "memory"); asm volatile("global_load_dwordx4 %0, %1, %2" : "=v"(dst[1]) : "v"(lo1), "s"(sb_) : "memory"); \
        asm volatile("global_load_dwordx4 %0, %1, %2" : "=v"(dst[2]) : "v"(lo2), "s"(sb_) : "memory"); asm volatile("global_load_dwordx4 %0, %1, %2" : "=v"(dst[3]) : "v"(lo3), "s"(sb_) : "memory"); } while (0)
#define PG8_CVW(src, b) do { asm volatile("" : "+v"(src[0]), "+v"(src[1]), "+v"(src[2]), "+v"(src[3])); _Pragma("unroll") for (int _i = 0; _i < 4; ++_i) { u32x2 w_; w_.x = pk2(src[_i].x, src[_i].y); w_.y = pk2(src[_i].z, src[_i].w); *(LAS u32x2*)(lds + (b) * HTB + awoff + _i * 128) = w_; } } while (0)
#define PG8_LDA(dst, b, h) do { _Pragma("unroll") for (int m = 0; m < 4; ++m) dst[m] = *(const LAS bf16x8*)(lds + (b) * HTB + aoff + m * 2048 + (h) * 1024); } while (0)
#define PG8_LDB(dst, sbo_, h) do { _Pragma("unroll") for (int n = 0; n < 2; ++n) _Pragma("unroll") for (int k = 0; k < 2; ++k) dst[n][k] = *(const LAS bf16x8*)(lds + (sbo_) + (h) * HTB + boff + n * 2048 + k * 1024); } while (0)
#define PG8_MMAK(kk, bj, At, Bt) do { __builtin_amdgcn_s_setprio(1); _Pragma("unroll") for (int m = 0; m < 4; ++m) _Pragma("unroll") for (int n = 0; n < 2; ++n) \
        acc[bj][m][n] = __builtin_amdgcn_mfma_f32_16x16x32_bf16(Bt[n][kk], At[m], acc[bj][m][n], 0, 0, 0); __builtin_amdgcn_s_setprio(0); } while (0)
#define PG8_WAIT_V(n) asm volatile("s_waitcnt vmcnt(" #n ")" ::: "memory")
#define PG8_WAIT_L(n) asm volatile("s_waitcnt lgkmcnt(" #n ")" ::: "memory")
#define PG8_MEMB asm volatile("" ::: "memory")
#define PG8_BAR __builtin_amdgcn_s_barrier()
#define PG8_SCHED __builtin_amdgcn_sched_barrier(0)
#define PG8_UBASE(u) ((size_t)__builtin_amdgcn_readfirstlane((int)ptl[((u).pm >> 4) * NPAGES + 8 * ((u).pm & 15) + wid]) * (size_t)(PAGE * 2048) + (size_t)(((u).pn >> 1) * 512))
#define PG8_BBASE(u) ((const char*)g.Bt + (size_t)((u).pn >> 1) * 2 * tstepB + (size_t)((u).pn & 1) * hstepB)
    LAS unsigned short* ptl = (LAS unsigned short*)(lds + STAGE_BYTES);
    for (int i = tid; i < NSMP * NPAGES; i += 512) ptl[i] = (unsigned short)g.pt[i];
    asm volatile("s_waitcnt vmcnt(0) lgkmcnt(0)" ::: "memory"); PG8_BAR;
    Unit cur, nxt; int ui = 0;
    if (!S.next(0, cur)) return;
    f32x4 acc[2][4][2];
#pragma unroll
    for (int b = 0; b < 2; ++b)
#pragma unroll
        for (int m = 0; m < 4; ++m)
#pragma unroll
            for (int n = 0; n < 2; ++n) acc[b][m][n] = (f32x4){0.f, 0.f, 0.f, 0.f};
    bf16x8 At[4], At1[4], B0[2][2], B1[2][2];
    f32x4 R0[4], R1[4], R2[4], R3[4];
    size_t uA = PG8_UBASE(cur), uN = uA;
    const char* cB = PG8_BBASE(cur);
    int sbo = 2 * HTB;
    PG8_LDR(R0, uA, 0); PG8_MEMB;
    PG8_STAGEB(2 * HTB, 0, cB); PG8_STAGEB(2 * HTB, 1, cB + tstepB);
    PG8_STAGEB(4 * HTB, 0, cB + kstepB); PG8_STAGEB(4 * HTB, 1, cB + tstepB + kstepB); PG8_MEMB;
    PG8_LDR(R1, uA, 1); PG8_LDR(R2, uA, 2); PG8_LDR(R3, uA, 3); PG8_MEMB;
    PG8_WAIT_V(20); PG8_CVW(R0, 0); PG8_MEMB;
    PG8_LDR(R0, uA, 4); PG8_MEMB;
    PG8_WAIT_V(8); PG8_WAIT_L(0);
    int sbp = 6 * HTB;
    if (wr == 1) PG8_BAR;
    PG8_BAR;
#define PG8_KT(j, RN) do { const int t_ = 4 * it + (j); \
        PG8_LDB(B0, sbo, 0); PG8_LDB(B1, sbo, 1); PG8_SCHED; PG8_LDA(At, (j) & 1, 0); PG8_LDA(At1, (j) & 1, 1); \
        { const int tb_ = t_ + 2; const bool nb_ = tb_ >= 16; const char* bs_ = (nb_ ? nB : cB) + (size_t)(nb_ ? tb_ - 16 : tb_) * kstepB; PG8_STAGEB(sbp, 0, bs_); PG8_STAGEB(sbp, 1, bs_ + tstepB); } \
        PG8_MEMB; PG8_SCHED; \
        PG8_CVW(RN, ((j) + 1) & 1); \
        { const int ta_ = t_ + 5; const bool na_ = ta_ >= 16; const size_t ub_ = na_ ? uN : uA; const int tl_ = na_ ? ta_ - 16 : ta_; PG8_LDR(RN, ub_, tl_); } \
        PG8_MEMB; \
        PG8_WAIT_V(12); PG8_WAIT_L(0); PG8_BAR; PG8_MMAK(0, 0, At, B0); PG8_MMAK(0, 1, At, B1); PG8_MMAK(1, 0, At1, B0); PG8_MMAK(1, 1, At1, B1); PG8_BAR; PG8_SCHED; \
        sbp = sbo; sbo = sbo == 6 * HTB ? 2 * HTB : sbo + 2 * HTB; } while (0)
    for (;;) {
        const bool has_next = S.next(ui + 1, nxt);
        uN = has_next ? PG8_UBASE(nxt) : uA;
        const char* nB = has_next ? PG8_BBASE(nxt) : cB;
#pragma nounroll
        for (int it = 0; it < 4; ++it) { PG8_KT(0, R1); PG8_KT(1, R2); PG8_KT(2, R3); PG8_KT(3, R0); }
        if (wr == 0) PG8_BAR;
        {
            const int rbase0 = ((cur.pm >> 4) * 2 + wr) * 1024 + 64 * (cur.pm & 15), cb0 = (cur.pn & 1) * HALF + wc * 32 + 8 * fq;
            E.unit(acc, cur.pn >> 1, rbase0, cb0, fr, lane);
        }
        if (!has_next) break;
#pragma unroll
        for (int b = 0; b < 2; ++b)
#pragma unroll
            for (int m = 0; m < 4; ++m)
#pragma unroll
                for (int n = 0; n < 2; ++n) acc[b][m][n] = (f32x4){0.f, 0.f, 0.f, 0.f};
        cur = nxt; cB = nB; uA = uN; ++ui;
        if (wr == 1) PG8_BAR;
    }
    PG8_WAIT_V(0);
    asm volatile("" :: "v"(R0[0]), "v"(R0[1]), "v"(R0[2]), "v"(R0[3]), "v"(R1[0]), "v"(R1[1]), "v"(R1[2]), "v"(R1[3]));
    asm volatile("" :: "v"(R2[0]), "v"(R2[1]), "v"(R2[2]), "v"(R2[3]), "v"(R3[0]), "v"(R3[1]), "v"(R3[2]), "v"(R3[3]));
    PG8_SCHED;
    PG8_BAR;
#undef PG8_STAGEB
#undef PG8_LDR
#undef PG8_CVW
#undef PG8_LDA
#undef PG8_LDB
#undef PG8_MMAK
#undef PG8_UBASE
#undef PG8_BBASE
#undef PG8_KT
#undef PG8_MEMB
#undef PG8_WAIT_V
#undef PG8_WAIT_L
#undef PG8_BAR
#undef PG8_SCHED
}
}
#define XB_TMO      128
#define XB_XCNT(j)  (256  + 64 * (j))
#define XB_XSUB(j)  (1280 + 64 * (j))
#define XB_XGEN(j)  (2304 + 64 * (j))
#define XB_TOP      3328
#define XB_TOPGEN   3392
#define XCD_BAR_WORDS 3456
#define XB_SPIN_CAP (1u << 18)

__device__ __forceinline__ unsigned xb_ld(unsigned* p)              { return __hip_atomic_load(p, __ATOMIC_RELAXED, __HIP_MEMORY_SCOPE_AGENT); }
__device__ __forceinline__ unsigned xb_add(unsigned* p, unsigned v) { return __hip_atomic_fetch_add(p, v, __ATOMIC_RELAXED, __HIP_MEMORY_SCOPE_AGENT); }
__device__ __forceinline__ unsigned xb_xcc_id() { return (unsigned)__builtin_amdgcn_s_getreg((3 << 11) | 20) & 0xFu; }
#define XB_SPIN(cond, bar) do { unsigned _sp = 0; while (cond) { __builtin_amdgcn_s_sleep(1); \
    if ((++_sp & 255u) == 0u) { if (xb_ld(&(bar)[XB_TMO])) break; if (_sp > XB_SPIN_CAP) { atomicAdd(&(bar)[XB_TMO], 1u); break; } } } } while (0)

struct XcdBarrier {
    unsigned* bar; unsigned x;
    volatile LAS unsigned* st;
};

__device__ __forceinline__ XcdBarrier xcd_barrier_post(unsigned* bar, volatile LAS unsigned* st) {
    XcdBarrier b; b.bar = bar; b.x = xb_xcc_id(); b.st = st;
    if (threadIdx.x == 0) (void)xb_add(&bar[XB_XCNT(b.x)], 1u);
    return b;
}
__device__ __forceinline__ void xcd_barrier_complete(unsigned* bar, unsigned x, unsigned& nloc, unsigned& nx) {
    const unsigned G = gridDim.x * gridDim.y * gridDim.z;
    unsigned sum, cnt, mine, sp = 0u;
    for (;;) {
        sum = 0u; cnt = 0u; mine = 0u;
#pragma unroll
        for (unsigned j = 0; j < 16; ++j) { const unsigned c = xb_ld(&bar[XB_XCNT(j)]); sum += c; cnt += (c > 0u) ? 1u : 0u; mine = (j == x) ? c : mine; }
        if (sum == G) break;
        __builtin_amdgcn_s_sleep(1);
        if ((++sp & 255u) == 0u) { if (xb_ld(&bar[XB_TMO])) break; if (sp > XB_SPIN_CAP) { atomicAdd(&bar[XB_TMO], 1u); break; } }
    }
    nloc = mine > 0u ? mine : 1u; nx = cnt > 0u ? cnt : 1u;
}

__device__ __forceinline__ void xcd_barrier(const XcdBarrier& b) {
    asm volatile("s_waitcnt vmcnt(0)" ::: "memory");
    __syncthreads();
    if (threadIdx.x == 0) {
        unsigned* bar = b.bar;
        __builtin_amdgcn_s_waitcnt(0);
        unsigned nloc = b.st[0], nx = b.st[1];
        if (nloc == 0u) { xcd_barrier_complete(bar, b.x, nloc, nx); b.st[0] = nloc; b.st[1] = nx; }
        const unsigned old = xb_add(&bar[XB_XSUB(b.x)], 1u);
        const unsigned gen = old / nloc;
        if (old + 1u == (gen + 1u) * nloc) {
            __builtin_amdgcn_fence(__ATOMIC_RELEASE, "agent");
            asm volatile("s_waitcnt vmcnt(0)" ::: "memory");
            const unsigned og = xb_add(&bar[XB_TOP], 1u);
            const unsigned tg = og / nx;
            if (og + 1u == (tg + 1u) * nx) xb_add(&bar[XB_TOPGEN], 1u);
            else XB_SPIN(xb_ld(&bar[XB_TOPGEN]) == tg, bar);
            __builtin_amdgcn_fence(__ATOMIC_ACQUIRE, "agent");
            xb_add(&bar[XB_XGEN(b.x)], 1u);
            asm volatile("s_waitcnt vmcnt(0)" ::: "memory");
        } else {
            XB_SPIN(xb_ld(&bar[XB_XGEN(b.x)]) == gen, bar);
            __builtin_amdgcn_fence(__ATOMIC_ACQUIRE, "agent");
            asm volatile("s_waitcnt vmcnt(0)" ::: "memory");
        }
    }
    __syncthreads();
}
__device__ __forceinline__ void xcd_flag_arrive(const XcdBarrier& b, unsigned* F) {
    asm volatile("s_waitcnt vmcnt(0)" ::: "memory");
    __syncthreads();
    if (threadIdx.x == 0) {
        __builtin_amdgcn_s_waitcnt(0);
        const unsigned nloc = b.st[0];
        const unsigned old = xb_add(&F[XB_XSUB(b.x)], 1u);
        if (old + 1u == nloc) { __builtin_amdgcn_fence(__ATOMIC_RELEASE, "agent"); asm volatile("s_waitcnt vmcnt(0)" ::: "memory"); xb_add(&F[XB_TOP], 1u); }
    }
}
__device__ __forceinline__ void xcd_flag_wait(const XcdBarrier& b, unsigned* F) {
    if (threadIdx.x == 0) {
        const unsigned nx = b.st[1];
        XB_SPIN(xb_ld(&F[XB_TOP]) < nx, b.bar);
        __builtin_amdgcn_fence(__ATOMIC_ACQUIRE, "agent");
        asm volatile("s_waitcnt vmcnt(0)" ::: "memory");
    }
    __syncthreads();
}
constexpr int NWAVES = 8;
constexpr int RING_BYTES = 139264, MISC_OFF = RING_BYTES + 320, LDS_BYTES = 147456;
enum { I_XP = 0, I_XS, I_CP, I_CS, I_CKV, I_CWIN, I_SC, I_SN, I_SM, I_PT, I_RB, I_WADA, I_BADA, I_GMIX, I_GFFN, I_WIN, I_GATEB, I_PE, I_W1, I_W2, I_GNORM, I_WBA, I_WBB, I_WOUT, I_WFI, I_WFO, I_WADAF, I_BADAF, I_GFIN, N_INPUTS };
struct Args { const void* in[N_INPUTS]; float* out; unsigned char* ws; int ph_lo, ph_hi; };
static_assert(sizeof(Args) == 256, "Args has no padding");
#define LDS_WAIT() asm volatile("s_waitcnt lgkmcnt(0)" ::: "memory")
#define VM_WAIT() asm volatile("s_waitcnt vmcnt(0)" ::: "memory")
#define INF(a, k) ((const float*)(a).in[k])

struct MapId { DI int operator()(int n) const { return n; } };
struct MapZ {
    DI int operator()(int n) const {
        if (n < 1280) return n;
        if (n < 1304) return 5376 + (n - 1280);
        if (n < 2840) return 1280 + (n - 1304);
        if (n < 2848) return 5400 + (n - 2840);
        if (n < 3360) return 2816 + (n - 2848);
        return 3328 + (n - 3360);
    }
};
struct MapFFI { DI int operator()(int n) const { return n < FFH ? 8 * (n >> 2) + (n & 3) : 8 * ((n - FFH) >> 2) + 4 + ((n - FFH) & 3); } };
template <class Map>
DI void transpose_item(const float* W, int N, bf16_t* WT, int ldt, int koff, LAS float* scr, int item, int lane, Map map) {
    const int nblk = N / 32, kb = item / nblk, nb = item % nblk, k0 = 64 * kb, n0 = 32 * nb;
    float tv[32];
#pragma unroll
    for (int i = 0; i < 32; ++i) tv[i] = W[(size_t)(k0 + 2 * i + (lane >> 5)) * N + n0 + (lane & 31)];
#pragma unroll
    for (int i = 0; i < 32; ++i) scr[(2 * i + (lane >> 5)) * 33 + (lane & 31)] = tv[i];
    LDS_WAIT(); asm volatile("" ::: "memory");
    const int c = lane & 7;
#pragma unroll
    for (int j = 0; j < 4; ++j) { const int n = (lane >> 3) + 8 * j; const LAS float* s = scr + (8 * c) * 33 + n;
        u32x4 o; o.x = pk2(s[0 * 33], s[1 * 33]); o.y = pk2(s[2 * 33], s[3 * 33]); o.z = pk2(s[4 * 33], s[5 * 33]); o.w = pk2(s[6 * 33], s[7 * 33]);
        *(u32x4*)(WT + (size_t)map(n0 + n) * ldt + koff + k0 + 8 * c) = o; }
    LDS_WAIT(); asm volatile("" ::: "memory");
}
DI bf16x8 pack8(f32x4 a, f32x4 b) { u32x4 p; p.x = pk2(a.x, a.y); p.y = pk2(a.z, a.w); p.z = pk2(b.x, b.y); p.w = pk2(b.z, b.w); return __builtin_bit_cast(bf16x8, p); }
DI void mod_task(const float* W, const float* bias, int N, int col0, const float* cp, const float* cs, float* out, LAS unsigned char* lds, int wave, int lane) {
    const int fr = lane & 15, fq = lane >> 4;
    f32x4 acc[3][2];
#pragma unroll
    for (int i = 0; i < 3; ++i) { acc[i][0] = (f32x4){0.f, 0.f, 0.f, 0.f}; acc[i][1] = acc[i][0]; }
    const float* arow[3];
#pragma unroll
    for (int i = 0; i < 3; ++i) { int r = 16 * i + fr; r = r < 40 ? r : 39; arow[i] = (r < 8 ? cp + (size_t)r * D : cs + (size_t)(r - 8) * D) + 8 * fq + 128 * wave; }
#pragma unroll
    for (int k0 = 0; k0 < 128; k0 += 32) {
        bf16x8 bfr[2];
#pragma unroll
        for (int n = 0; n < 2; ++n) { const float* wp = W + (size_t)(128 * wave + k0 + 8 * fq) * N + col0 + 16 * n + fr;
            float w[8];
#pragma unroll
            for (int j = 0; j < 8; ++j) w[j] = wp[(size_t)j * N];
            u32x4 p; p.x = pk2(w[0], w[1]); p.y = pk2(w[2], w[3]); p.z = pk2(w[4], w[5]); p.w = pk2(w[6], w[7]); bfr[n] = __builtin_bit_cast(bf16x8, p); }
#pragma unroll
        for (int i = 0; i < 3; ++i) { const f32x4 a0 = *(const f32x4*)(arow[i] + k0), a1 = *(const f32x4*)(arow[i] + k0 + 4); const bf16x8 af = pack8(a0, a1);
#pragma unroll
            for (int n = 0; n < 2; ++n) acc[i][n] = __builtin_amdgcn_mfma_f32_16x16x32_bf16(af, bfr[n], acc[i][n], 0, 0, 0); }
    }
    LAS float* P = (LAS float*)lds;
#pragma unroll
    for (int i = 0; i < 3; ++i)
#pragma unroll
        for (int n = 0; n < 2; ++n)
#pragma unroll
            for (int j = 0; j < 4; ++j) P[(wave * 48 + 16 * i + 4 * fq + j) * 32 + 16 * n + fr] = acc[i][n][j];
    __syncthreads();
    for (int o = wave * 64 + lane; o < 40 * 32; o += 512) { const int r = o >> 5, c = o & 31; float t = bias[col0 + c];
#pragma unroll
        for (int w = 0; w < 8; ++w) t += P[(w * 48 + r) * 32 + c];
        out[(size_t)r * N + col0 + c] = t; }
    __syncthreads();
}
DI void conv_range(const Args& a, int it0, int it_end, int step, int lane) {
    unsigned char* ws = a.ws;
    const float* ckv = INF(a, I_CKV); const int* pt = (const int*)a.in[I_PT];
    const int pr = lane >> 5, c8 = lane & 31, seg = c8 >> 3, kind = seg >> 1, g = seg & 1, d = (c8 & 7) * 8;
    bf16_t* dbase = (bf16_t*)(ws + WS_ABF + (size_t)kind * ABF_KIND) + (size_t)AROWS_P * 1024 + d;
    for (int it = it0; it < it_end; it += 2 * step) {
        f32x4 v[2][4][2]; bf16_t* dst[2];
#pragma unroll
        for (int u = 0; u < 2; ++u) { const int itu = it + u * step; const int itc = itu < it_end ? itu : it;
            const int s = itc >> 11, rem = itc & 2047, p = rem >> 4, slot0 = (rem & 15) * 8 + pr;
            const int page = pt[s * NPAGES + p];
            const float* src = ckv + ((size_t)page * PAGE + slot0) * 512 + c8 * 8;
            dst[u] = dbase + ((size_t)(s * 2 + g) * 1024) * 1024 + (size_t)(p * PAGE + slot0) * 64;
#pragma unroll
            for (int i = 0; i < 4; ++i) { v[u][i][0] = __builtin_nontemporal_load((const f32x4*)(src + i * 1024)); v[u][i][1] = __builtin_nontemporal_load((const f32x4*)(src + i * 1024 + 4)); } }
#pragma unroll
        for (int u = 0; u < 2; ++u)
#pragma unroll
            for (int i = 0; i < 4; ++i) { u32x4 o; o.x = pk2(v[u][i][0].x, v[u][i][0].y); o.y = pk2(v[u][i][0].z, v[u][i][0].w); o.z = pk2(v[u][i][1].x, v[u][i][1].y); o.w = pk2(v[u][i][1].z, v[u][i][1].w); *(u32x4*)(dst[u] + i * 128) = o; }
    }
}
#ifndef PRETOUCH
#define PRETOUCH 0
#endif
DI void touch_region(const void* base, size_t bytes, int gt, int NGT) {
    const char* p = (const char*)base; unsigned acc = 0u;
    for (size_t o = (size_t)gt * 65536; o < bytes; o += (size_t)NGT * 65536) acc += __builtin_nontemporal_load((const unsigned*)(p + o));
    asm volatile("" :: "v"(acc));
}
DI void p0_prologue(const Args& a, LAS unsigned char* lds, int gw, int NGW, int wave, int lane) {
    unsigned char* ws = a.ws;
    if (PRETOUCH) { const int gt = gw * 64 + lane, NGT = NGW * 64;
        touch_region(ws, WS_END, gt, NGT); touch_region(a.in[I_CKV], (size_t)5120 * 128 * 512 * 4, gt, NGT); touch_region(a.in[I_XP], (size_t)MPR * D * 4, gt, NGT); touch_region(a.out, O_END * 4, gt, NGT);
        touch_region(a.in[I_WADA], (size_t)1024 * 6144 * 4, gt, NGT); touch_region(a.in[I_WIN], (size_t)1024 * NIN * 4, gt, NGT); touch_region(a.in[I_WFI], (size_t)1024 * NFF * 4, gt, NGT); touch_region(a.in[I_WFO], (size_t)FFH * 1024 * 4, gt, NGT);
        touch_region(a.in[I_CWIN], (size_t)NSMP * 512 * 256 * 4, gt, NGT); touch_region(a.in[I_SC], (size_t)NSMP * 4 * 16384 * 4, gt, NGT); }
    for (int task = gw >> 3; task < 256; task += NGW >> 3) {
        if (task < 192) mod_task(INF(a, I_WADA), INF(a, I_BADA), 6144, task * 32, INF(a, I_CP), INF(a, I_CS), (float*)(ws + WS_MOD), lds, wave, lane);
        else mod_task(INF(a, I_WADAF), INF(a, I_BADAF), 2048, (task - 192) * 32, INF(a, I_CP), INF(a, I_CS), (float*)(ws + WS_MODF), lds, wave, lane);
    }
    {
        LAS float* scr = (LAS float*)(lds + wave * 16384);
        constexpr int I_A = 16 * 169;
        for (int it = gw; it < I_A; it += NGW) transpose_item(INF(a, I_WIN), NIN, (bf16_t*)(ws + WS_WIN_T), 1024, 0, scr, it, lane, MapZ());
    }
}
DI void cbias_task(const Args& a, LAS unsigned char* lds, int task, int wave, int lane) {
    unsigned char* ws = a.ws;
    const int kind = task >> 2, f = (task & 3) * 64 + lane; const float* pe = INF(a, I_PE) + kind * 2048 + wave * 256; const float* w1 = INF(a, I_W1) + ((size_t)kind * 2048 + wave * 256) * 256 + f;
    float sacc[4] = {0.f, 0.f, 0.f, 0.f};
#pragma unroll 8
    for (int k = 0; k < 256; k += 4) {
#pragma unroll
        for (int j = 0; j < 4; ++j) sacc[j] += pe[k + j] * w1[(size_t)(k + j) * 256]; }
    LAS float* red = (LAS float*)lds;
    __syncthreads();
    red[wave * 64 + lane] = (sacc[0] + sacc[1]) + (sacc[2] + sacc[3]);
    __syncthreads();
    if (wave == 0) { float t = 0.f;
#pragma unroll
        for (int w = 0; w < 8; ++w) t += red[w * 64 + lane];
        ((float*)(ws + WS_CBIAS))[kind * 256 + f] = t; }
    __syncthreads();
}
template <int PART> DI void late_transposes(const Args& a, LAS unsigned char* lds, int widx, int nw, int wave, int lane) {
    unsigned char* ws = a.ws;
    LAS float* scr = (LAS float*)(lds + wave * 16384);
    constexpr int I_B = 8 * 32, I_C = 8 * 32, I_D = 16 * 32, I_E = 16 * 176, I_F = 44 * 32, I_G = 32 * 8, I_H = 4 * 2;
    constexpr int NITEMS = PART == 0 ? 2 * I_G + 2 * I_H + I_B + I_C + I_D + I_E : (PART == 2 ? 2 * I_G : I_F);
    for (int it = widx; it < NITEMS; it += nw) {
        int r = it;
        if (PART == 1) { transpose_item(INF(a, I_WFO), 1024, (bf16_t*)(ws + WS_WFO_T), FFH, 0, scr, r, lane, MapId()); continue; }
        if (PART == 0) { if (r < 2 * I_G) { const int kind = r / I_G; transpose_item(INF(a, I_W1) + (size_t)kind * 2048 * 256, 256, (bf16_t*)(ws + WS_W1C_T) + (size_t)kind * 256 * 2048, 2048, 0, scr, r % I_G, lane, MapId()); continue; } r -= 2 * I_G; }
        if (PART == 2) { const int kind = r / I_G, it2 = r % I_G, upper = (it2 / 8) >= 16;
            transpose_item(INF(a, I_W1) + (size_t)kind * 2048 * 256, 256, (bf16_t*)(ws + WS_W1P_T) + (size_t)kind * 512 * 1024 + (upper ? 256 * 1024 : 0), 1024, upper ? -1024 : 0, scr, it2, lane, MapId()); continue; }
        if (r < 2 * I_H) { const int kind = r / I_H; transpose_item(INF(a, I_W2) + (size_t)kind * 256 * 64, 64, (bf16_t*)(ws + WS_W2C_T) + (size_t)kind * 64 * 256, 256, 0, scr, r % I_H, lane, MapId()); continue; } r -= 2 * I_H;
        if (r < I_B) { transpose_item(INF(a, I_WBA), 1024, (bf16_t*)(ws + WS_WBR_T), 1024, 0, scr, r, lane, MapId()); continue; } r -= I_B;
        if (r < I_C) { transpose_item(INF(a, I_WBB), 1024, (bf16_t*)(ws + WS_WBR_T), 1024, 512, scr, r, lane, MapId()); continue; } r -= I_C;
        if (r < I_D) { transpose_item(INF(a, I_WOUT), 1024, (bf16_t*)(ws + WS_WOUT_T), 1024, 0, scr, r, lane, MapId()); continue; } r -= I_D;
        if (r < I_E) { transpose_item(INF(a, I_WFI), NFF, (bf16_t*)(ws + WS_WFI_T), 1024, 0, scr, r, lane, MapFFI()); continue; } r -= I_E;
        transpose_item(INF(a, I_WFO), 1024, (bf16_t*)(ws + WS_WFO_T), FFH, 0, scr, r, lane, MapId());
    }
}
DI void win_copy(const Args& a, int widx, int nw, int lane) {
    const float* cw = INF(a, I_CWIN); float* ow = a.out + O_WINS;
    for (int it0 = widx * 4; it0 < NSMP * 511; it0 += nw * 4) { f32x4 v[4];
#pragma unroll
        for (int u = 0; u < 4; ++u) { const int it = it0 + u < NSMP * 511 ? it0 + u : it0; const int s = it / 511, w = it % 511; v[u] = *(const f32x4*)(cw + ((size_t)s * 512 + w + 1) * 256 + lane * 4); }
#pragma unroll
        for (int u = 0; u < 4; ++u) { const int it = it0 + u < NSMP * 511 ? it0 + u : it0; const int s = it / 511, w = it % 511; *(f32x4*)(ow + ((size_t)s * 512 + w) * 256 + lane * 4) = v[u]; }
    }
}
template <bool BF> DI void norm_load(const void* xrv, int lane, f32x4 (&v)[4]) {
#pragma unroll
    for (int j = 0; j < 4; ++j) {
        if (BF) { const u32x2 w = *(const u32x2*)((const bf16_t*)xrv + 4 * lane + 256 * j); v[j] = (f32x4){bf2f(w.x & 0xffffu), bf2f(w.x >> 16), bf2f(w.y & 0xffffu), bf2f(w.y >> 16)}; }
        else v[j] = *(const f32x4*)((const float*)xrv + 4 * lane + 256 * j); }
}
DI void norm_finish(f32x4 (&v)[4], const float* g, const float* shift, const float* scale, int lane) {
    float s = 0.f;
#pragma unroll
    for (int j = 0; j < 4; ++j) s += (v[j].x * v[j].x + v[j].y * v[j].y) + (v[j].z * v[j].z + v[j].w * v[j].w);
    const float rstd = 1.f / sqrtf(wave_sum(s) * (1.f / D) + EPS);
#pragma unroll
    for (int j = 0; j < 4; ++j) { const int c = 4 * lane + 256 * j; const f32x4 gv = *(const f32x4*)(g + c), sh = *(const f32x4*)(shift + c), sc = *(const f32x4*)(scale + c);
        v[j] = (v[j] * rstd) * gv * (sc + 1.f) + sh; }
}
DI void norm_phase_bf16(const Args& a, int which, int gw, int NGW, int lane) {
    unsigned char* ws = a.ws; bf16_t* U = (bf16_t*)(ws + WS_U); const float* mod = (const float*)(ws + WS_MOD);
    const float* g = INF(a, which == 0 ? I_GMIX : I_GFFN);
    for (int row0 = gw; row0 < MP; row0 += 2 * NGW) {
        f32x4 v[2][4]; int rows[2]; rows[0] = row0; rows[1] = row0 + NGW;
#pragma unroll
        for (int u = 0; u < 2; ++u) { const int row = rows[u]; if (row < MREAL) {
            if (which == 0) norm_load<false>(row < MPR ? INF(a, I_XP) + (size_t)row * D : INF(a, I_XS) + (size_t)(row - MPR) * D, lane, v[u]);
            else norm_load<true>((const bf16_t*)(ws + WS_X1) + (size_t)row * D, lane, v[u]); } }
#pragma unroll
        for (int u = 0; u < 2; ++u) { const int row = rows[u]; if (row >= MP) continue;
            u32x2* o = (u32x2*)(U + (size_t)row * D) + lane;
            if (row >= MREAL) { for (int j = 0; j < 4; ++j) o[64 * j] = (u32x2){0u, 0u}; continue; }
            const int mrow = row < MPR ? (row >> 11) : 8 + (row - MPR);
            const float* mr = mod + (size_t)mrow * 6144 + (which == 0 ? 0 : 3 * 1024);
            norm_finish(v[u], g, mr, mr + 1024, lane);
#pragma unroll
            for (int j = 0; j < 4; ++j) { u32x2 w; w.x = pk2(v[u][j].x, v[u][j].y); w.y = pk2(v[u][j].z, v[u][j].w); o[64 * j] = w; } }
    }
}
DI void final_norm_phase(const Args& a, int gw, int NGW, int lane) {
    unsigned char* ws = a.ws; const float* modf = (const float*)(ws + WS_MODF); const float* g = INF(a, I_GFIN);
    for (int row0 = gw; row0 < MREAL; row0 += 2 * NGW) {
        f32x4 v[2][4]; int rows[2]; rows[0] = row0; rows[1] = row0 + NGW;
#pragma unroll
        for (int u = 0; u < 2; ++u) if (rows[u] < MREAL) norm_load<true>((const bf16_t*)(ws + WS_X2) + (size_t)rows[u] * D, lane, v[u]);
#pragma unroll
        for (int u = 0; u < 2; ++u) { const int row = rows[u]; if (row >= MREAL) continue;
            const int mrow = row < MPR ? (row >> 11) : 8 + (row - MPR);
            const float* mr = modf + (size_t)mrow * 2048;
            norm_finish(v[u], g, mr, mr + 1024, lane);
            float* o = (row < MPR ? a.out + O_Y + (size_t)row * D : a.out + O_YS + (size_t)(row - MPR) * D) + 4 * lane;
#pragma unroll
            for (int j = 0; j < 4; ++j) *(f32x4*)(o + 256 * j) = v[u][j]; }
    }
}
DI float gelu_tanh(float x) { const float x2 = x * x; const float ny = x * (x2 * (-0.044715f * 1.5957691216057308f * 1.4426950408889634f) - 1.5957691216057308f * 1.4426950408889634f);
    return x * __builtin_amdgcn_rcpf(1.f + __builtin_amdgcn_exp2f(ny)); }
DI int paoff(int row, int ch) { return row * 512 + ((ch ^ (row & 15)) << 4); }
DI void pcmp_unit(const Args& a, LAS unsigned char* lds, int kind, int seq, int quarter, int wave, int lane) {
    unsigned char* ws = a.ws;
    const int tid = wave * 64 + lane;
    const int fr = lane & 15, fq = lane >> 4;
    const int arow0 = seq * 128 + 32 * quarter;
    const bf16_t* Ab = (const bf16_t*)(ws + WS_ABF + (size_t)kind * ABF_KIND) + (size_t)arow0 * 1024;
    const bf16_t* B = (const bf16_t*)(ws + WS_W1C_T) + (size_t)kind * 256 * 2048 + (size_t)(32 * wave + fr) * 2048 + 8 * fq;
    f32x4 acc[2][2];
#pragma unroll
    for (int i = 0; i < 2; ++i) { acc[i][0] = (f32x4){0.f, 0.f, 0.f, 0.f}; acc[i][1] = acc[i][0]; }
    u32x4 areg[2];
#pragma unroll
    for (int i = 0; i < 2; ++i) { const int idx = tid + 512 * i, rw = idx >> 5, ch = idx & 31; areg[i] = *(const u32x4*)(Ab + (size_t)rw * 1024 + ch * 8); }
    __syncthreads();
#pragma unroll 1
    for (int kc = 0; kc < 8; ++kc) {
        LAS unsigned char* abuf = lds + 65536 + (kc & 1) * 32768;
#pragma unroll
        for (int i = 0; i < 2; ++i) { const int idx = tid + 512 * i, rw = idx >> 5, ch = idx & 31; *(LAS u32x4*)(abuf + paoff(rw, ch)) = areg[i]; }
        __syncthreads();
        if (kc + 1 < 8) {
#pragma unroll
            for (int i = 0; i < 2; ++i) { const int idx = tid + 512 * i, rw = idx >> 5, ch = idx & 31; areg[i] = *(const u32x4*)(Ab + (size_t)rw * 1024 + (kc + 1) * 256 + ch * 8); } }
        bf16x8 bfr[8][2];
#pragma unroll
        for (int ks = 0; ks < 8; ++ks)
#pragma unroll
            for (int nt = 0; nt < 2; ++nt) bfr[ks][nt] = *(const bf16x8*)(B + (size_t)nt * 16 * 2048 + kc * 256 + 32 * ks);
#pragma unroll
        for (int ks = 0; ks < 8; ++ks)
#pragma unroll
            for (int mt = 0; mt < 2; ++mt) { const bf16x8 af = *(const LAS bf16x8*)(abuf + paoff(16 * mt + fr, 4 * ks + fq));
#pragma unroll
                for (int nt = 0; nt < 2; ++nt) acc[mt][nt] = __builtin_amdgcn_mfma_f32_16x16x32_bf16(af, bfr[ks][nt], acc[mt][nt], 0, 0, 0); }
    }
    LAS bf16_t* G = (LAS bf16_t*)lds;
    const float* cb = (const float*)(ws + WS_CBIAS) + kind * 256;
    __syncthreads();
#pragma unroll
    for (int mt = 0; mt < 2; ++mt)
#pragma unroll
        for (int nt = 0; nt < 2; ++nt) { const int col = 32 * wave + 16 * nt + fr; const float bv = cb[col];
#pragma unroll
            for (int j = 0; j < 4; ++j) G[(16 * mt + 4 * fq + j) * 264 + col] = (bf16_t)(pk2(gelu_tanh(acc[mt][nt][j] + bv), 0.f) & 0xffffu); }
    __syncthreads();
    {
        const int mt = wave >> 2, nt = wave & 3; const bf16_t* w2 = (const bf16_t*)(ws + WS_W2C_T) + (size_t)kind * 64 * 256 + (size_t)fr * 256 + 8 * fq;
        bf16_t* kc = (bf16_t*)(ws + WS_KC) + ((size_t)kind * AROWS + arow0 + 16 * mt) * 64;
        f32x4 c = {0.f, 0.f, 0.f, 0.f};
#pragma unroll
        for (int ks = 0; ks < 8; ++ks) { const bf16x8 af = *(const LAS bf16x8*)(G + (16 * mt + fr) * 264 + 32 * ks + 8 * fq); const bf16x8 bfr = *(const bf16x8*)(w2 + (size_t)nt * 16 * 256 + 32 * ks);
            c = __builtin_amdgcn_mfma_f32_16x16x32_bf16(af, bfr, c, 0, 0, 0); }
#pragma unroll
        for (int j = 0; j < 4; ++j) kc[(size_t)(4 * fq + j) * 64 + nt * 16 + fr] = (bf16_t)(pk2(c[j], 0.f) & 0xffffu);
    }
    __syncthreads();
}
DI void scan_unit(const Args& a, int task, int lane) {
    unsigned char* ws = a.ws;
    const int b = task >> 2, h = task & 3; const float* ga = (const float*)(ws + WS_GA) + (size_t)(b * T + lane) * 32;
    float ipv[32], fpv[32];
#pragma unroll
    for (int c = 0; c < 32; ++c) { ipv[c] = ga[(size_t)c * 64 * 32 + 24 + h]; fpv[c] = ga[(size_t)c * 64 * 32 + 28 + h]; }
    float Bc = 0.f, pm = 0.f;
    float* AL = (float*)(ws + WS_ALPHA) + task * 2048; float* BE = (float*)(ws + WS_BETA) + task * 2048; float* MT = (float*)(ws + WS_MT) + task * 2048;
#pragma unroll
    for (int c = 0; c < 32; ++c) {
        const int t = 64 * c + lane; const float ip = ipv[c], fp = fpv[c];
        float lf = fminf(fp, 0.f) - log1pf(__expf(-fabsf(fp)));
#pragma unroll
        for (int o = 1; o < 64; o <<= 1) { const float u = __shfl_up(lf, o); if (lane >= o) lf += u; }
        const float Bt = Bc + lf, beta = ip - Bt;
        float mx = beta;
#pragma unroll
        for (int o = 1; o < 64; o <<= 1) { const float u = __shfl_up(mx, o); if (lane >= o) mx = fmaxf(mx, u); }
        mx = fmaxf(mx, pm);
        AL[t] = -mx; BE[t] = beta; MT[t] = Bt + mx;
        Bc = __shfl(Bt, 63); pm = __shfl(mx, 63);
        if (c == 31 && lane == 63) a.out[O_MP + task] = Bt + mx;
    }
}
constexpr int W2_LDS = 65536;
DI void st8bf_(bf16_t* p, f32x4 v0, f32x4 v1) { u32x4 w; w.x = pk2(v0.x, v0.y); w.y = pk2(v0.z, v0.w); w.z = pk2(v1.x, v1.y); w.w = pk2(v1.z, v1.w); *(u32x4*)p = w; }
DI int w2off(int n, int ch) { return n * 512 + ((ch ^ (n & 31)) << 4); }
DI void w2_load(const Args& a, int task, int lane, u32x4 (&x0)[8], u32x4 (&x1)[8]) {
    const int fr = lane & 15, fq = lane >> 4;
    const int kind = task / (AROWS_S / 16), pr0 = (task % (AROWS_S / 16)) * 16;
    const bf16_t* h0 = (const bf16_t*)(a.ws + WS_GH) + ((size_t)kind * AROWS_S + pr0 + fr) * 256 + 8 * fq;
    const bool bnd = (task & 3) == 3 && fr == 15;
    const int hb = ((pr0 + 16) >> 6) < 1023 ? ((pr0 + 16) >> 6) : 1023;
    const bf16_t* h1 = (const bf16_t*)(a.ws + WS_GH) + (size_t)2 * AROWS_S * 256 + ((size_t)kind * 1024 + hb) * 256 + 8 * fq;
#pragma unroll
    for (int ks = 0; ks < 8; ++ks) { x0[ks] = *(const u32x4*)(h0 + 32 * ks); x1[ks] = bnd ? *(const u32x4*)(h1 + 32 * ks) : (u32x4){0u, 0u, 0u, 0u}; }
}
DI void w2_compute(const Args& a, LAS unsigned char* lds, int task, int lane, const u32x4 (&x0)[8], const u32x4 (&x1)[8]) {
    unsigned char* ws = a.ws;
    const int fr = lane & 15, fq = lane >> 4;
    const int kind = task / (AROWS_S / 16), row0 = AROWS_P + (task % (AROWS_S / 16)) * 16;
    const float* cb = (const float*)(ws + WS_CBIAS) + kind * 256 + 8 * fq;
    bf16x8 af[8];
#pragma unroll
    for (int ks = 0; ks < 8; ++ks) { const f32x4 c0 = *(const f32x4*)(cb + 32 * ks), c1 = *(const f32x4*)(cb + 32 * ks + 4);
        f32x4 g0, g1;
        g0.x = gelu_tanh(bf2f(x0[ks].x & 0xffffu) + bf2f(x1[ks].x & 0xffffu) + c0.x); g0.y = gelu_tanh(bf2f(x0[ks].x >> 16) + bf2f(x1[ks].x >> 16) + c0.y);
        g0.z = gelu_tanh(bf2f(x0[ks].y & 0xffffu) + bf2f(x1[ks].y & 0xffffu) + c0.z); g0.w = gelu_tanh(bf2f(x0[ks].y >> 16) + bf2f(x1[ks].y >> 16) + c0.w);
        g1.x = gelu_tanh(bf2f(x0[ks].z & 0xffffu) + bf2f(x1[ks].z & 0xffffu) + c1.x); g1.y = gelu_tanh(bf2f(x0[ks].z >> 16) + bf2f(x1[ks].z >> 16) + c1.y);
        g1.z = gelu_tanh(bf2f(x0[ks].w & 0xffffu) + bf2f(x1[ks].w & 0xffffu) + c1.z); g1.w = gelu_tanh(bf2f(x0[ks].w >> 16) + bf2f(x1[ks].w >> 16) + c1.w);
        af[ks] = pack8(g0, g1); }
    const LAS unsigned char* wl = lds + W2_LDS + kind * 32768;
    f32x4 acc[4];
#pragma unroll
    for (int nt = 0; nt < 4; ++nt) { acc[nt] = (f32x4){0.f, 0.f, 0.f, 0.f};
#pragma unroll
        for (int ks = 0; ks < 8; ++ks) { const bf16x8 wfr = *(const LAS bf16x8*)(wl + w2off(16 * (fr >> 2) + 4 * nt + (fr & 3), 4 * ks + fq)); acc[nt] = __builtin_amdgcn_mfma_f32_16x16x32_bf16(wfr, af[ks], acc[nt], 0, 0, 0); } }
    bf16_t* kc = (bf16_t*)(ws + WS_KC) + ((size_t)kind * AROWS + row0 + fr) * 64 + 16 * fq;
    st8bf_(kc, acc[0], acc[1]); st8bf_(kc + 8, acc[2], acc[3]);
}
DI void w2_stage(const Args& a, LAS unsigned char* lds, int tid) {
    volatile LAS int* W2F = (volatile LAS int*)(lds + RING_BYTES + 192);
    if (__builtin_amdgcn_readfirstlane(*W2F) == 0) {
        const bf16_t* src = (const bf16_t*)(a.ws + WS_W2C_T);
        for (int i = tid; i < 2 * 64 * 32; i += 512) { const int kind = i >> 11, n = (i >> 5) & 63, ch = i & 31;
            *(LAS u32x4*)(lds + W2_LDS + kind * 32768 + w2off(n, ch)) = *(const u32x4*)(src + ((size_t)kind * 64 + n) * 256 + ch * 8); }
        __syncthreads();
        if (tid == 0) *W2F = 1;
    }
}
DI void w2_unit(const Args& a, LAS unsigned char* lds, int v, int wave, int lane) {
    const int tid = wave * 64 + lane;
    w2_stage(a, lds, tid);
    const int t0 = 32 * v + 4 * wave;
    u32x4 xa0[8], xa1[8], xb0[8], xb1[8];
    w2_load(a, t0, lane, xa0, xa1);
    w2_load(a, t0 + 1, lane, xb0, xb1);
    w2_compute(a, lds, t0, lane, xa0, xa1);
    w2_load(a, t0 + 2, lane, xa0, xa1);
    w2_compute(a, lds, t0 + 1, lane, xb0, xb1);
    w2_load(a, t0 + 3, lane, xb0, xb1);
    w2_compute(a, lds, t0 + 2, lane, xa0, xa1);
    w2_compute(a, lds, t0 + 3, lane, xb0, xb1);
}
DI void st8bf(bf16_t* p, f32x4 v0, f32x4 v1) { u32x4 w; w.x = pk2(v0.x, v0.y); w.y = pk2(v0.z, v0.w); w.z = pk2(v1.x, v1.y); w.w = pk2(v1.z, v1.w); *(u32x4*)p = w; }
DI f32x4 sig4(f32x4 v) { f32x4 o; o.x = sigmoidf_(v.x); o.y = sigmoidf_(v.y); o.z = sigmoidf_(v.z); o.w = sigmoidf_(v.w); return o; }
DI f32x4 ld4bf(const bf16_t* p) { const u32x2 w = *(const u32x2*)p; f32x4 o; o.x = bf2f(w.x & 0xffffu); o.y = bf2f(w.x >> 16); o.z = bf2f(w.y & 0xffffu); o.w = bf2f(w.y >> 16); return o; }
constexpr float KSCALE = 0.08838834764831845f;

struct EpiZ {
    static constexpr bool HAS_MID = false; static constexpr int MID_T = 0;
    bf16_t *QA, *KVB, *QB, *KB, *VB, *OB, *GM, *ABF; float* GA; float* out; const float* gate_b;
    DI void mid(f32x4 (&)[2][2][4][2], const pg8::Unit&, int, int, int, int) const {}
    DI void elem(int row, int col0, f32x4 v0, f32x4 v1) const {
        const int tile = col0 >> 8;
        if (tile < 2) { st8bf(QA + (size_t)row * 512 + col0, v0 * QSCALE, v1 * QSCALE); }
        else if (tile < 5) {
            const int kv = col0 - 512;
            if (kv < 256) {
                if (row < MPR) { const int kind = kv >> 7, g = (kv >> 6) & 1, d = kv & 63, b = row >> 11, t = row & 2047;
                    st8bf(ABF + (size_t)kind * (ABF_KIND / 2) + ((size_t)(b * 2 + g) * 128) * 1024 + (size_t)t * 64 + d, v0, v1); }
            } else st8bf(KVB + (size_t)row * 512 + (kv - 256), v0, v1);
            if (kv < 512) {
                if (row < MPR) { float* o = out + O_KVP + (size_t)row * 512 + kv; *(f32x4*)o = v0; *(f32x4*)(o + 4) = v1; }
                else if (row < MREAL) { float* o = out + O_KVS + (size_t)(row - MPR) * 512 + kv; *(f32x4*)o = v0; *(f32x4*)(o + 4) = v1; }
            } else {
                const int wc = kv - 512;
                if (row < MPR) { const int t = row & 2047; if (t >= 1536) { float* o = out + O_WINP + ((size_t)(row >> 11) * 512 + (t - 1536)) * 256 + wc; *(f32x4*)o = v0; *(f32x4*)(o + 4) = v1; } }
                else if (row < MREAL) { float* o = out + O_WINS + ((size_t)(row - MPR) * 512 + 511) * 256 + wc; *(f32x4*)o = v0; *(f32x4*)(o + 4) = v1; }
            }
        }
        else if (tile < 7) st8bf(QB + (size_t)row * 512 + (col0 - 1280), v0, v1);
        else if (tile < 9) st8bf(KB + (size_t)row * 512 + (col0 - 1792), v0 * KSCALE, v1 * KSCALE);
        else if (tile < 11) st8bf(VB + (size_t)row * 512 + (col0 - 2304), v0, v1);
        else if (tile < 13) st8bf(OB + (size_t)row * 512 + (col0 - 2816), sig4(v0), sig4(v1));
        else if (tile < 21) st8bf(GM + (size_t)row * 2048 + (col0 - 3328), sig4(v0), sig4(v1));
        else { const int c = col0 - 5376; float* o = GA + (size_t)row * 32 + c;
            if (c < 24) { *(f32x4*)o = sig4(v0); *(f32x4*)(o + 4) = sig4(v1); }
            else if (c < 32) { *(f32x4*)o = v0 + *(const f32x4*)gate_b; *(f32x4*)(o + 4) = v1 + *(const f32x4*)(gate_b + 4); } }
    }
};
struct EpiPiece {
    static constexpr bool HAS_MID = false; static constexpr int MID_T = 0;
    bf16_t* H;
    DI void mid(f32x4 (&)[2][2][4][2], const pg8::Unit&, int, int, int, int) const {}
    DI void elem(int row, int col0, f32x4 v0, f32x4 v1) const { st8bf(H + (size_t)row * 512 + col0, v0, v1); }
};
struct EpiHid {
    bf16_t* HID0; bf16_t* HB10;
    DI void unit(const f32x4 (&acc)[2][4][2], int kind, int rbase0, int cb0, int fr, int lane) const {
        bf16_t* HID = HID0 + (size_t)kind * AROWS_S * 256; bf16_t* HB1 = HB10 + (size_t)kind * 1024 * 256;
        const int src = ((lane & 48) | ((lane + 1) & 15)) << 2;
#pragma unroll
        for (int m = 0; m < 4; ++m) { f32x4 sv[2];
#pragma unroll
            for (int n = 0; n < 2; ++n)
#pragma unroll
                for (int j = 0; j < 4; ++j) { const float x = acc[1][m][n][j], xn = m < 3 ? acc[1][m + 1][n][j] : x; const float y = fr == 0 ? xn : x;
                    const float sh = __builtin_bit_cast(float, __builtin_amdgcn_ds_bpermute(src, __builtin_bit_cast(int, y)));
                    sv[n][j] = acc[0][m][n][j] + ((m == 3 && fr == 15) ? 0.f : sh); }
            st8bf(HID + (size_t)(rbase0 + m * 16 + fr) * 256 + cb0, sv[0], sv[1]); }
        if (fr == 0) st8bf(HB1 + (size_t)(rbase0 >> 6) * 256 + cb0, acc[1][0][0], acc[1][0][1]);
    }
};
struct EpiCmp {
    static constexpr bool HAS_MID = false; static constexpr int MID_T = 0;
    bf16_t* GH; const float* cbias;
    DI void mid(f32x4 (&)[2][2][4][2], const pg8::Unit&, int, int, int, int) const {}
    static DI float gelu(float x) { const float y = 1.5957691216057308f * (x + 0.044715f * x * x * x); return x / (1.f + __expf(-y)); }
    DI void elem(int row, int col0, f32x4 v0, f32x4 v1) const {
        v0 = v0 + *(const f32x4*)(cbias + col0); v1 = v1 + *(const f32x4*)(cbias + col0 + 4);
        f32x4 a, b; a.x = gelu(v0.x); a.y = gelu(v0.y); a.z = gelu(v0.z); a.w = gelu(v0.w); b.x = gelu(v1.x); b.y = gelu(v1.y); b.z = gelu(v1.z); b.w = gelu(v1.w);
        st8bf(GH + (size_t)row * 256 + col0, a, b);
    }
};
struct EpiBr {
    static constexpr bool HAS_MID = true; static constexpr int MID_T = 8;
    const bf16_t* GM; bf16_t* MIX;
    DI void mid(f32x4 (&acc)[2][2][4][2], const pg8::Unit& u, int wr, int wc, int fr, int fq) const {
        const bf16_t* p0 = GM + (size_t)(u.pm * 256 + wr * 64 + fr) * 2048 + u.pn * 256 + wc * 32 + 8 * fq;
        asm volatile("" : "+v"(p0));
#pragma unroll
        for (int ai = 0; ai < 2; ++ai)
#pragma unroll
            for (int m = 0; m < 4; ++m)
#pragma unroll
                for (int bj = 0; bj < 2; ++bj) { const bf16_t* p = p0 + (size_t)(ai * 128 + m * 16) * 2048 + bj * 128;
                    const u32x4 ga = *(const u32x4*)p, gb = *(const u32x4*)(p + 1024);
                    f32x4 r0, r1;
                    r0.x = bf2f(ga.x & 0xffffu) * __builtin_amdgcn_rcpf(bf2f(gb.x & 0xffffu)); r0.y = bf2f(ga.x >> 16) * __builtin_amdgcn_rcpf(bf2f(gb.x >> 16));
                    r0.z = bf2f(ga.y & 0xffffu) * __builtin_amdgcn_rcpf(bf2f(gb.y & 0xffffu)); r0.w = bf2f(ga.y >> 16) * __builtin_amdgcn_rcpf(bf2f(gb.y >> 16));
                    r1.x = bf2f(ga.z & 0xffffu) * __builtin_amdgcn_rcpf(bf2f(gb.z & 0xffffu)); r1.y = bf2f(ga.z >> 16) * __builtin_amdgcn_rcpf(bf2f(gb.z >> 16));
                    r1.z = bf2f(ga.w & 0xffffu) * __builtin_amdgcn_rcpf(bf2f(gb.w & 0xffffu)); r1.w = bf2f(ga.w >> 16) * __builtin_amdgcn_rcpf(bf2f(gb.w >> 16));
                    acc[ai][bj][m][0] = acc[ai][bj][m][0] * r0; acc[ai][bj][m][1] = acc[ai][bj][m][1] * r1; }
    }
    DI void elem(int row, int col0, f32x4 v0, f32x4 v1) const {
        const bf16_t* p = GM + (size_t)row * 2048 + 1024 + col0;
        st8bf(MIX + (size_t)row * 1024 + col0, v0 * ld4bf(p), v1 * ld4bf(p + 4));
    }
    DI void elem2(int row, int col0, f32x4 a0, f32x4 a1, f32x4 b0, f32x4 b1) const {
        const bf16_t* p = GM + (size_t)row * 2048 + col0;
        st8bf(MIX + (size_t)row * 1024 + col0, a0 * ld4bf(p) + b0 * ld4bf(p + 1024), a1 * ld4bf(p + 4) + b1 * ld4bf(p + 1028));
    }
};
struct EpiRes {
    static constexpr bool HAS_MID = false; static constexpr int MID_T = 0;
    const float *xp, *xs; bf16_t* XO; const float* mod; int goff; const bf16_t* xin;
    DI void mid(f32x4 (&)[2][2][4][2], const pg8::Unit&, int, int, int, int) const {}
    DI void elem(int row, int col0, f32x4 v0, f32x4 v1) const {
        if (row >= MREAL) return;
        const int mrow = row < MPR ? (row >> 11) : 8 + (row - MPR);
        const float* gp = mod + (size_t)mrow * 6144 + goff + col0;
        f32x4 s0, s1;
        if (xin) { s0 = ld4bf(xin + (size_t)row * D + col0); s1 = ld4bf(xin + (size_t)row * D + col0 + 4); }
        else { const float* src = row < MPR ? xp + (size_t)row * D + col0 : xs + (size_t)(row - MPR) * D + col0; s0 = *(const f32x4*)src; s1 = *(const f32x4*)(src + 4); }
        st8bf(XO + (size_t)row * D + col0, s0 + *(const f32x4*)gp * v0, s1 + *(const f32x4*)(gp + 4) * v1);
    }
};
struct EpiSwiGLU {
    static constexpr bool HAS_MID = false; static constexpr int MID_T = 0;
    bf16_t* H;
    DI void mid(f32x4 (&)[2][2][4][2], const pg8::Unit&, int, int, int, int) const {}
    DI void elem(int row, int col0, f32x4 v0, f32x4 v1) const {
        const f32x4 s = sig4(v0); const f32x4 o = v0 * s * v1; u32x2 w; w.x = pk2(o.x, o.y); w.y = pk2(o.z, o.w);
        *(u32x2*)(H + (size_t)row * FFH + (col0 >> 1)) = w;
    }
};

template <class Epi>
DI void skinny_task(LAS unsigned char* lds, const bf16_t* A, int lda, const bf16_t* Bt, int K, int n0, const Epi& E, int wave, int lane) {
    const int fr = lane & 15, fq = lane >> 4, ksl = K >> 3;
    f32x4 acc[2][2];
#pragma unroll
    for (int i = 0; i < 2; ++i) { acc[i][0] = (f32x4){0.f, 0.f, 0.f, 0.f}; acc[i][1] = acc[i][0]; }
    const bf16_t* ap = A + (size_t)fr * lda + wave * ksl + 8 * fq;
    const bf16_t* bp = Bt + (size_t)(n0 + 8 * (fr >> 2) + (fr & 3)) * K + wave * ksl + 8 * fq;
#pragma unroll 2
    for (int k = 0; k < ksl; k += 32) {
        const bf16x8 a0 = *(const bf16x8*)(ap + k), a1 = *(const bf16x8*)(ap + (size_t)16 * lda + k);
        const bf16x8 b0 = *(const bf16x8*)(bp + k), b1 = *(const bf16x8*)(bp + (size_t)4 * K + k);
        acc[0][0] = __builtin_amdgcn_mfma_f32_16x16x32_bf16(b0, a0, acc[0][0], 0, 0, 0); acc[0][1] = __builtin_amdgcn_mfma_f32_16x16x32_bf16(b1, a0, acc[0][1], 0, 0, 0);
        acc[1][0] = __builtin_amdgcn_mfma_f32_16x16x32_bf16(b0, a1, acc[1][0], 0, 0, 0); acc[1][1] = __builtin_amdgcn_mfma_f32_16x16x32_bf16(b1, a1, acc[1][1], 0, 0, 0);
    }
    LAS float* P = (LAS float*)lds;
    __syncthreads();
#pragma unroll
    for (int mt = 0; mt < 2; ++mt)
#pragma unroll
        for (int nt = 0; nt < 2; ++nt) *(LAS f32x4*)(P + (wave * 32 + 16 * mt + fr) * 32 + 8 * fq + 4 * nt) = acc[mt][nt];
    __syncthreads();
    const int tid = wave * 64 + lane;
    if (tid < 128) { const int row = tid >> 2, cg = tid & 3;
        f32x4 s[2][2];
#pragma unroll
        for (int hf = 0; hf < 2; ++hf) { s[hf][0] = (f32x4){0.f, 0.f, 0.f, 0.f}; s[hf][1] = s[hf][0];
#pragma unroll
            for (int w = 0; w < 4; ++w) { const LAS float* p = P + ((4 * hf + w) * 32 + row) * 32 + 8 * cg; s[hf][0] = s[hf][0] + *(const LAS f32x4*)p; s[hf][1] = s[hf][1] + *(const LAS f32x4*)(p + 4); } }
        if constexpr (Epi::HAS_MID) E.elem2(MPR + row, n0 + 8 * cg, s[0][0], s[0][1], s[1][0], s[1][1]);
        else E.elem(MPR + row, n0 + 8 * cg, s[0][0] + s[1][0], s[0][1] + s[1][1]); }
    __syncthreads();
}
template <class Epi>
DI void skinny_phase(LAS unsigned char* lds, const bf16_t* A, int lda, const bf16_t* Bt, int K, int N, int nunits, const Epi& E, int bx, int G, int wave, int lane) {
    const int rem = nunits % G, nlight = rem ? G - rem : G, me = G - 1 - bx;
    if (me < nlight) for (int t = me; t < N / 32; t += nlight) skinny_task<Epi>(lds, A + (size_t)MPR * lda, lda, Bt, K, 32 * t, E, wave, lane);
}
constexpr int A_KS = 0, A_VS = 16384, A_LUT = 32768, A_IMPH = 46080, A_SC = 82944, A_MASK = 91392, A_MISC = 91648;
constexpr int LUTN = 832;
DI int swz64(int row) { return (((row >> 1) & 1) << 2) | ((row >> 2) & 3); }
DI int off64(int row, int ch) { return row * 128 + ((ch ^ swz64(row)) << 4); }
DI int swz128(int row) { return ((row & 3) << 2) | ((row >> 2) & 3); }
DI int off128(int row, int ch) { return row * 256 + ((ch ^ swz128(row)) << 4); }
DI int crow(int reg, int h) { return (reg & 3) + 8 * (reg >> 2) + 4 * h; }
DI s16x4 vtr(const LAS unsigned char* p) { return __builtin_bit_cast(s16x4, __builtin_amdgcn_ds_read_tr16_b64_v4i16((LAS v4i16_t*)p)); }
#define MFMA32(a, b, c) __builtin_amdgcn_mfma_f32_32x32x16_bf16((a), (b), (c), 0, 0, 0)
template <int S> DI bf16x8 pack_step(const f32x16& x) { u32x4 p; p.x = pk2(x[8 * S], x[8 * S + 1]); p.y = pk2(x[8 * S + 2], x[8 * S + 3]); p.z = pk2(x[8 * S + 4], x[8 * S + 5]); p.w = pk2(x[8 * S + 6], x[8 * S + 7]); return __builtin_bit_cast(bf16x8, p); }
DI f32x16 zero16() { f32x16 z; for (int i = 0; i < 16; ++i) z[i] = 0.f; return z; }
DI int rel_bucket(int d) {
    if (d < 16) return d < 0 ? 0 : d;
    int b = 16;
    b += (d >= 21) + (d >= 27) + (d >= 35) + (d >= 46) + (d >= 59) + (d >= 77) + (d >= 99) + (d >= 128) + (d >= 166) + (d >= 216) + (d >= 280) + (d >= 363) + (d >= 470) + (d >= 609) + (d >= 790);
    return b;
}
DI f32x16 qk64_rb(const LAS unsigned char* Ks, int rb, const bf16x8 (&qf)[4], int r, int h2) {
    f32x16 s = zero16();
#pragma unroll
    for (int ks = 0; ks < 4; ++ks) { const bf16x8 kf = *(const LAS bf16x8*)(Ks + off64(32 * rb + r, 2 * ks + h2)); s = MFMA32(kf, qf[ks], s); }
    return s;
}
DI void pv64_rb(f32x16 (&O)[2], const f32x16& P, const LAS unsigned char* Vs, int rb, int lane) {
    const int i16 = lane & 15, q = i16 >> 2, p = i16 & 3, blk = (lane >> 4) & 1, h2 = lane >> 5;
    const bf16x8 pb0 = pack_step<0>(P), pb1 = pack_step<1>(P);
#pragma unroll
    for (int s = 0; s < 2; ++s) {
        const int rlo = 32 * rb + 16 * s + 4 * h2 + q;
#pragma unroll
        for (int db = 0; db < 2; ++db) { const int dcol = 32 * db + 16 * blk + 4 * p, ch = dcol >> 3, sub = (dcol & 7) * 2;
            const s16x4 lo = vtr(Vs + off64(rlo, ch) + sub), hi = vtr(Vs + off64(rlo + 8, ch) + sub);
            const bf16x8 va = __builtin_shufflevector(lo, hi, 0, 1, 2, 3, 4, 5, 6, 7);
            O[db] = MFMA32(va, s == 0 ? pb0 : pb1, O[db]); }
    }
}
constexpr int LUTR_N = 992, LOFF = 915;
constexpr int N_KT0 = 0, N_VT0 = 8192, N_KT1 = 16384, N_VT1 = 24576, N_LUT = 32768, N_IMPH = N_LUT + 2 * 4 * LUTR_N * 4, N_SC = 0, N_E0 = N_IMPH + 4 * 64 * 33 * 4, N_E1 = N_E0 + 16384, N_MASK = N_E1 + 16384, N_END = N_MASK + 512;
static_assert(N_END <= 139264, "NSA LDS map");
constexpr float RESC_THR = 8.f;
DI float ex2(float x) { return __builtin_amdgcn_exp2f(x); }
DI float pairmax32(float x) { const unsigned u = __builtin_bit_cast(unsigned, x); const auto r = __builtin_amdgcn_permlane32_swap(u, u, false, false);
    return fmaxf(__builtin_bit_cast(float, r[0]), __builtin_bit_cast(float, r[1])); }
DI float max3f(float a, float b, float c) { return fmaxf(fmaxf(a, b), c); }
template <bool NEAR, int MASK>
DI void nsa_tile2(f32x16 (&O)[2], float& l, float& inited, f32x16& negm, const LAS unsigned char* Kb, const LAS unsigned char* Vb, const int (&ka)[4], const int (&va)[4], const bf16x8 (&qf)[4],
                  const LAS float* lutp, float c31, int dlim, bool tok) {
    f32x16 S[2];
#pragma unroll
    for (int rb = 0; rb < 2; ++rb) { const bf16x8 kf0 = *(const LAS bf16x8*)(Kb + ka[0] + rb * 4096); S[rb] = MFMA32(kf0, qf[0], negm);
#pragma unroll
        for (int ks = 1; ks < 4; ++ks) { const bf16x8 kf = *(const LAS bf16x8*)(Kb + ka[ks] + rb * 4096); S[rb] = MFMA32(kf, qf[ks], S[rb]); } }
    float mx = -INFINITY;
#pragma unroll
    for (int rb = 0; rb < 2; ++rb)
#pragma unroll
        for (int reg = 0; reg < 16; ++reg) { const int c = 32 * rb + (reg & 3) + 8 * (reg >> 2); float sv = S[rb][reg];
            if (NEAR) sv += lutp[c]; else sv += c31;
            if (MASK == 1) sv = c <= dlim ? sv : -INFINITY;
            if (MASK == 2) sv = c > dlim - 512 ? sv : -INFINITY;
            S[rb][reg] = sv; mx = fmaxf(mx, sv); }
    mx = tok ? mx : -INFINITY;
    mx = pairmax32(mx);
    const bool need = mx > RESC_THR || (inited == 0.f && mx > -INFINITY);
    if (__builtin_amdgcn_ballot_w64(need) != 0ull) {
        float delta = 0.f;
        if (mx > -INFINITY) { delta = inited == 0.f ? mx : fmaxf(mx, 0.f); inited = 1.f; }
        const float alpha = ex2(-delta);
        l *= alpha;
#pragma unroll
        for (int reg = 0; reg < 16; ++reg) { O[0][reg] *= alpha; O[1][reg] *= alpha; negm[reg] -= delta; S[0][reg] -= delta; S[1][reg] -= delta; }
    }
    float ls = 0.f;
#pragma unroll
    for (int rb = 0; rb < 2; ++rb)
#pragma unroll
        for (int reg = 0; reg < 16; ++reg) { const float p = ex2(S[rb][reg]); S[rb][reg] = p; ls += p; }
    ls = tok ? ls : 0.f;
    l += ls;
    const unsigned pmask = tok ? 0xffffffffu : 0u;
#pragma unroll
    for (int rb = 0; rb < 2; ++rb) {
        u32x4 pa = __builtin_bit_cast(u32x4, pack_step<0>(S[rb])), pb = __builtin_bit_cast(u32x4, pack_step<1>(S[rb]));
        pa.x &= pmask; pa.y &= pmask; pa.z &= pmask; pa.w &= pmask; pb.x &= pmask; pb.y &= pmask; pb.z &= pmask; pb.w &= pmask;
#pragma unroll
        for (int s = 0; s < 2; ++s)
#pragma unroll
            for (int db = 0; db < 2; ++db) {
                const s16x4 lo = vtr(Vb + va[db] + rb * 4096 + s * 2048), hi = vtr(Vb + va[2 + db] + rb * 4096 + s * 2048);
                const bf16x8 vf = __builtin_shufflevector(lo, hi, 0, 1, 2, 3, 4, 5, 6, 7);
                O[db] = MFMA32(vf, __builtin_bit_cast(bf16x8, s == 0 ? pa : pb), O[db]); }
    }
}
DI void nsa_acc_out(f32x16 (&OUT)[2], const f32x16 (&O)[2], float l, float gate) {
    const float lt = l + __shfl_xor(l, 32); const float sc = gate / fmaxf(lt, 1e-30f);
#pragma unroll
    for (int db = 0; db < 2; ++db)
#pragma unroll
        for (int reg = 0; reg < 16; ++reg) OUT[db][reg] += O[db][reg] * sc;
}
DI void nsa_unit(const Args& a, LAS unsigned char* lds, int b, int g, int jb) {
    unsigned char* ws = a.ws;
    int tid_ = threadIdx.x; asm volatile("" : "+v"(tid_));
    const int tid = tid_, lane = tid & 63, wave = __builtin_amdgcn_readfirstlane(tid >> 6), hh = wave & 3, th = wave >> 2, r = lane & 31, h2 = lane >> 5;
    const int q0 = 64 * jb, tl = 32 * th + r, t = q0 + tl; const size_t row = (size_t)b * T + t;
    const bf16_t* QA = (const bf16_t*)(ws + WS_QA); const bf16_t* KVB = (const bf16_t*)(ws + WS_KVB); const bf16_t* KC = (const bf16_t*)(ws + WS_KC);
    LAS float* LUT = (LAS float*)(lds + N_LUT); LAS float* IMPH = (LAS float*)(lds + N_IMPH); LAS float* SC = (LAS float*)(lds + N_SC); LAS unsigned* MASK = (LAS unsigned*)(lds + N_MASK); LAS unsigned* ANYW = (LAS unsigned*)(lds + N_MASK + 256);
    const float* rbp = INF(a, I_RB);
    __syncthreads();
    if (tid == 0) *ANYW = 0u;
    const bf16_t* ksb = KVB + (size_t)b * T * 512 + g * 64;
    const int drow = 8 * wave + (lane >> 3), dgoff = drow * 512 + (((lane & 7) ^ swz64(drow)) << 3);
#define NSA_SLOT(sidx) ((sidx) == 0 ? N_E0 : ((sidx) == 1 ? N_E1 : ((sidx) < 4 ? ((sidx) - 2) * 16384 : N_IMPH + ((sidx) - 4) * 16384)))
#define NSA_DMA(isw, tile, sidx) do { const int so_ = NSA_SLOT(sidx); const bf16_t* kb_ = ksb + ((isw) ? 256 : 0) + dgoff + (size_t)(64 * (tile)) * 512; \
        __builtin_amdgcn_global_load_lds((const unsigned*)kb_, (LAS unsigned*)(lds + so_ + wave * 1024), 16, 0, 0); \
        __builtin_amdgcn_global_load_lds((const unsigned*)(kb_ + 128), (LAS unsigned*)(lds + so_ + 8192 + wave * 1024), 16, 0, 0); } while (0)
    const unsigned upto = jb == 31 ? 0xffffffffu : ((2u << jb) - 1u);
    unsigned pfw = upto & ~((1u << (jb > 8 ? jb - 8 : 0)) - 1u);
    int spf = 0;
#pragma unroll 1
    for (int n = 0; n < 2; ++n) if (pfw) { const int tp = __builtin_ctz(pfw); pfw &= pfw - 1u; NSA_DMA(true, tp, spf); ++spf; }
    volatile LAS int* LUTG = (volatile LAS int*)(lds + RING_BYTES + 128);
    LUT += g * 4 * LUTR_N;
    if (__builtin_amdgcn_readfirstlane(LUTG[g]) == 0) {
        for (int i = tid; i < 4 * LUTR_N; i += 512) { const int h = i / LUTR_N, x = i - h * LUTR_N, d = LOFF - x; LUT[i] = d >= 0 ? rbp[rel_bucket(d) * 8 + g * 4 + h] * LOG2E : 0.f; }
        __syncthreads();
        if (tid == 0) LUTG[g] = 1;
    }
    { const bf16_t* kc = KC + ((size_t)(b * 2 + g) * 128) * 64; const bf16_t* vc = kc + (size_t)AROWS * 64;
#pragma unroll
      for (int i = 0; i < 2; ++i) { const int idx = tid + 512 * i, rw = idx >> 3, ch = idx & 7;
          *(LAS u32x4*)(lds + off64(rw, ch)) = *(const u32x4*)(kc + (size_t)rw * 64 + ch * 8); *(LAS u32x4*)(lds + 16384 + off64(rw, ch)) = *(const u32x4*)(vc + (size_t)rw * 64 + ch * 8); } }
    bf16x8 qf[4];
#pragma unroll
    for (int ks = 0; ks < 4; ++ks) qf[ks] = *(const bf16x8*)(QA + row * 512 + (g * 4 + hh) * 64 + 16 * ks + 8 * h2);
    const float* ga = (const float*)(ws + WS_GA) + row * 32 + (g * 4 + hh) * 3;
    const float gate_c = ga[0], gate_s = ga[1], gate_w = ga[2];
    const float c31 = rbp[31 * 8 + g * 4 + hh] * LOG2E;
    const LAS float* lut = LUT + hh * LUTR_N;
    __syncthreads();
    float* oscr = (float*)(ws + WS_NSCR) + ((size_t)(blockIdx.x * 8 + wave) * 32) * 64 + lane;
    {
        f32x16 OUT[2]; OUT[0] = zero16(); OUT[1] = zero16();
        const LAS unsigned char* Ks = lds; const LAS unsigned char* Vs = lds + 16384;
        f32x16 S[4];
#pragma unroll
        for (int rb = 0; rb < 4; ++rb) S[rb] = qk64_rb(Ks, rb, qf, r, h2);
        float mx = -INFINITY;
#pragma unroll
        for (int rb = 0; rb < 4; ++rb)
#pragma unroll
            for (int reg = 0; reg < 16; ++reg) { const int i = 32 * rb + crow(reg, h2), dist = t - (16 * i + 31);
                const bool valid = dist >= 0 && i < 127; const int xi = dist < 0 ? LOFF + 1 : LOFF - (dist > LOFF ? LOFF : dist);
                const float sv = valid ? S[rb][reg] + lut[xi] : -INFINITY; S[rb][reg] = sv; mx = fmaxf(mx, sv); }
        mx = fmaxf(mx, __shfl_xor(mx, 32));
        const float ms = mx == -INFINITY ? 0.f : mx;
        float ls = 0.f;
#pragma unroll
        for (int rb = 0; rb < 4; ++rb)
#pragma unroll
            for (int reg = 0; reg < 16; ++reg) { const float p = ex2(S[rb][reg] - ms); S[rb][reg] = p; ls += p; }
        ls += __shfl_xor(ls, 32);
        const float inv = ls > 0.f ? 1.f / fmaxf(ls, 1e-30f) : 0.f;
#pragma unroll
        for (int rb = 0; rb < 4; ++rb)
#pragma unroll
            for (int reg = 0; reg < 16; ++reg) S[rb][reg] *= inv;
        LAS float* ip = IMPH + (hh * 64 + tl) * 33;
#pragma unroll
        for (int rb = 0; rb < 4; ++rb)
#pragma unroll
            for (int rg = 0; rg < 4; ++rg) ip[8 * rb + 2 * rg + h2] = (S[rb][4 * rg] + S[rb][4 * rg + 1]) + (S[rb][4 * rg + 2] + S[rb][4 * rg + 3]);
        if (h2 == 0) ip[32] = 0.f;
        LDS_WAIT(); asm volatile("" ::: "memory");
        {
            float cv[16];
#pragma unroll
            for (int rb = 0; rb < 4; ++rb)
#pragma unroll
                for (int rg = 0; rg < 4; ++rg) cv[4 * rb + rg] = ip[8 * rb + 2 * rg + h2 + 1];
            LDS_WAIT(); asm volatile("" ::: "memory");
#pragma unroll
            for (int rb = 0; rb < 4; ++rb)
#pragma unroll
                for (int rg = 0; rg < 4; ++rg) ip[8 * rb + 2 * rg + h2 + 1] = cv[4 * rb + rg] + S[rb][4 * rg + 3];
        }
#pragma unroll
        for (int rb = 0; rb < 4; ++rb) {
#pragma unroll
            for (int reg = 0; reg < 16; ++reg) S[rb][reg] *= gate_c;
            pv64_rb(OUT, S[rb], Vs, rb, lane); }
#pragma unroll
        for (int db = 0; db < 2; ++db)
#pragma unroll
            for (int reg = 0; reg < 16; ++reg) oscr[(db * 16 + reg) * 64] = OUT[db][reg];
    }
    __syncthreads();
    if (jb >= 16) {
        for (int idx = tid; idx < 64 * 32; idx += 512) { const int tk = idx >> 5, j = idx & 31;
            const float imp = (IMPH[(0 * 64 + tk) * 33 + j] + IMPH[(1 * 64 + tk) * 33 + j]) + (IMPH[(2 * 64 + tk) * 33 + j] + IMPH[(3 * 64 + tk) * 33 + j]);
            const bool valid = j <= jb, forced = (j == 0) || (j == jb) || (j == jb - 1);
            SC[tk * 33 + j] = valid ? (forced ? 1e9f : imp) : -1e30f; }
        __syncthreads();
        for (int idx = tid; idx < 64 * 32; idx += 512) { const int tk = idx >> 5, j = idx & 31; const float my = SC[tk * 33 + j]; int rank = 0;
#pragma unroll 8
            for (int k = 0; k < 32; ++k) { const float o = SC[tk * 33 + k]; rank += (o > my || (o == my && k < j)) ? 1 : 0; }
            const bool sel = rank < 16 && j <= jb;
            const unsigned long long bal = __ballot(sel);
            if (j == 0) { const unsigned mk = (unsigned)(bal >> (32 * (lane >> 5))); MASK[tk] = mk; __hip_atomic_fetch_or(ANYW, mk, __ATOMIC_RELAXED, __HIP_MEMORY_SCOPE_WORKGROUP); } }
    } else if (tid < 64) { MASK[tid] = (2u << jb) - 1u; if (tid == 0) *ANYW = (2u << jb) - 1u; }
    __syncthreads();
    const unsigned tmask = MASK[tl];
    const unsigned any = __builtin_amdgcn_readfirstlane(*ANYW);
    int ka[4], va[4];
    { const int i16 = lane & 15, q = i16 >> 2, p4 = i16 & 3, blk = (lane >> 4) & 1;
#pragma unroll
      for (int ks = 0; ks < 4; ++ks) ka[ks] = off64(r, 2 * ks + h2);
#pragma unroll
      for (int hi = 0; hi < 2; ++hi)
#pragma unroll
          for (int db = 0; db < 2; ++db) { const int dcol = 32 * db + 16 * blk + 4 * p4; va[2 * hi + db] = off64(4 * h2 + q + 8 * hi, dcol >> 3) + (dcol & 7) * 2; } }
    {
        unsigned remw = upto & ~((1u << (jb > 8 ? jb - 8 : 0)) - 1u), rems = any & upto;
        unsigned pfs = rems;
        int scur = 0;
        f32x16 O[2]; O[0] = zero16(); O[1] = zero16(); float l = 0.f, inited = 0.f;
        f32x16 negm = zero16();
        bool in_win = true;
        VM_WAIT();
        __syncthreads();
        { if (pfw) { const int tp = __builtin_ctz(pfw); pfw &= pfw - 1u; NSA_DMA(true, tp, spf); spf = spf == 5 ? 0 : spf + 1; }
          else if (pfs) { const int tp = __builtin_ctz(pfs); pfs &= pfs - 1u; NSA_DMA(false, tp, spf); spf = spf == 5 ? 0 : spf + 1; } }
        while (remw | rems) {
            const bool isw = remw != 0u;
            if (!isw && in_win) {
                const float lt = l + __shfl_xor(l, 32); const float sc = gate_w / fmaxf(lt, 1e-30f);
#pragma unroll
                for (int db = 0; db < 2; ++db)
#pragma unroll
                    for (int reg = 0; reg < 16; ++reg) oscr[(db * 16 + reg) * 64] += O[db][reg] * sc;
                O[0] = zero16(); O[1] = zero16(); l = 0.f; inited = 0.f; negm = zero16(); in_win = false;
            }
            int kt;
            if (isw) { kt = __builtin_ctz(remw); remw &= remw - 1u; } else { kt = __builtin_ctz(rems); rems &= rems - 1u; }
            bool issued = false;
            if (pfw) { const int tp = __builtin_ctz(pfw); pfw &= pfw - 1u; NSA_DMA(true, tp, spf); spf = spf == 5 ? 0 : spf + 1; issued = true; }
            else if (pfs) { const int tp = __builtin_ctz(pfs); pfs &= pfs - 1u; NSA_DMA(false, tp, spf); spf = spf == 5 ? 0 : spf + 1; issued = true; }
            int boff = NSA_SLOT(scur);
            asm volatile("" : "+s"(boff));
            const LAS unsigned char* Kb = lds + boff; const LAS unsigned char* Vb = Kb + 8192;
            const int key0 = 64 * kt, dlim = t - key0 - 4 * h2;
            const LAS float* lutp = lut + (LOFF - dlim);
            const bool tok = isw ? true : ((tmask >> kt) & 1u) != 0u;
            if (__ballot(tok) != 0ull) {
                if (kt == jb) nsa_tile2<true, 1>(O, l, inited, negm, Kb, Vb, ka, va, qf, lutp, c31, dlim, tok);
                else if (isw && kt == jb - 8) nsa_tile2<true, 2>(O, l, inited, negm, Kb, Vb, ka, va, qf, lutp, c31, dlim, tok);
                else if (!isw && key0 + 63 + 790 <= q0 + 32 * th) nsa_tile2<false, 0>(O, l, inited, negm, Kb, Vb, ka, va, qf, lutp, c31, dlim, tok);
                else nsa_tile2<true, 0>(O, l, inited, negm, Kb, Vb, ka, va, qf, lutp, c31, dlim, tok);
            }
            if (issued) asm volatile("s_waitcnt vmcnt(4)" ::: "memory"); else VM_WAIT();
            __syncthreads();
            scur = scur == 5 ? 0 : scur + 1;
        }
        {
            const float lt = l + __shfl_xor(l, 32); const float sc = gate_s / fmaxf(lt, 1e-30f);
            bf16_t* op = (bf16_t*)(ws + WS_OAHB) + row * 1024 + (g * 4 + hh) * 64;
#pragma unroll
            for (int db = 0; db < 2; ++db)
#pragma unroll
                for (int rg = 0; rg < 4; ++rg) { float o[4];
#pragma unroll
                    for (int i = 0; i < 4; ++i) o[i] = oscr[(db * 16 + 4 * rg + i) * 64] + O[db][4 * rg + i] * sc;
                    u32x2 w; w.x = pk2(o[0], o[1]); w.y = pk2(o[2], o[3]); *(u32x2*)(op + 32 * db + 8 * rg + 4 * h2) = w; }
        }
    }
#undef NSA_SLOT
#undef NSA_DMA
}

constexpr int M_BS = 32768, M_KAP = 33024, M_NV = 33280, M_CT = 36864;
DI void mlstm_unit(const Args& a, LAS unsigned char* lds, int b, int h, int J) {
    unsigned char* ws = a.ws;
    int tid_ = threadIdx.x; asm volatile("" : "+v"(tid_));
    const int tid = tid_, lane = tid & 63, wave = __builtin_amdgcn_readfirstlane(tid >> 6), r = lane & 31, h2 = lane >> 5;
    const int seq = b * 4 + h, t = 256 * J + 32 * wave + r; const size_t row = (size_t)b * T + t;
    const bf16_t* QB = (const bf16_t*)(ws + WS_QB); const bf16_t* KB = (const bf16_t*)(ws + WS_KB) + (size_t)b * T * 512 + h * 128; const bf16_t* VB = (const bf16_t*)(ws + WS_VB) + (size_t)b * T * 512 + h * 128;
    const float* BETA = (const float*)(ws + WS_BETA) + seq * 2048; const float* ALPHA = (const float*)(ws + WS_ALPHA) + seq * 2048; const float* MTG = (const float*)(ws + WS_MT) + seq * 2048;
    const LAS unsigned char* Ks = lds + A_KS; const LAS unsigned char* Vs = lds + A_VS; LAS float* BS = (LAS float*)(lds + M_BS); LAS float* KAP = (LAS float*)(lds + M_KAP); LAS float* NV = (LAS float*)(lds + M_NV);
    bf16x8 qf[8];
#pragma unroll
    for (int ks = 0; ks < 8; ++ks) qf[ks] = *(const bf16x8*)(QB + row * 512 + h * 128 + 16 * ks + 8 * h2);
    const float aln = ALPHA[t], al = aln * LOG2E, mt = MTG[t];
    f32x16 O[4];
#pragma unroll
    for (int i = 0; i < 4; ++i) O[i] = zero16();
    float den = 0.f;
    __syncthreads();
    if (J > 0) {
        const int e1 = 256 * J - 1;
        if (tid < J) { const int ep = 256 * tid + 255; const float Be1 = ALPHA[e1] + MTG[e1], Bep = ALPHA[ep] + MTG[ep];
            KAP[tid] = __expf((Be1 - Bep) + ((const float*)(ws + WS_MU))[seq * 8 + tid] - MTG[e1]); }
        __syncthreads();
        {
            f32x4 cacc[8];
#pragma unroll
            for (int i = 0; i < 8; ++i) cacc[i] = (f32x4){0.f, 0.f, 0.f, 0.f};
            float nacc = 0.f;
            const float* dc = (const float*)(ws + WS_DC) + (size_t)seq * 8 * 16384 + tid * 4; const float* dn = (const float*)(ws + WS_DN) + seq * 8 * 128;
#pragma unroll 1
            for (int jp = 0; jp < J; ++jp) { const float f = KAP[jp];
#pragma unroll
                for (int i = 0; i < 8; ++i) cacc[i] = cacc[i] + *(const f32x4*)(dc + (size_t)jp * 16384 + 2048 * i) * f;
                if (tid < 128) nacc += dn[jp * 128 + tid] * f; }
#pragma unroll
            for (int i = 0; i < 8; ++i) { const int e = (tid + 512 * i) * 4, dk = e >> 7, dv = e & 127;
#pragma unroll
                for (int j = 0; j < 4; ++j) *(LAS unsigned short*)(lds + M_CT + off128(dv + j, dk >> 3) + (dk & 7) * 2) = (unsigned short)(pk2(cacc[i][j], 0.f) & 0xffffu); }
            if (tid < 128) NV[tid] = nacc;
        }
        __syncthreads();
#pragma unroll
        for (int db = 0; db < 4; ++db)
#pragma unroll
            for (int ks = 0; ks < 8; ++ks) { const bf16x8 cf = *(const LAS bf16x8*)(lds + M_CT + off128(32 * db + r, 2 * ks + h2)); O[db] = MFMA32(cf, qf[ks], O[db]); }
        const float sc = __expf(aln - ALPHA[e1]);
#pragma unroll
        for (int db = 0; db < 4; ++db)
#pragma unroll
            for (int reg = 0; reg < 16; ++reg) O[db][reg] *= sc;
        float qn = 0.f;
#pragma unroll
        for (int ks = 0; ks < 8; ++ks) { const u32x4 qw = __builtin_bit_cast(u32x4, qf[ks]); const f32x4 n0 = *(const LAS f32x4*)(NV + 16 * ks + 8 * h2), n1 = *(const LAS f32x4*)(NV + 16 * ks + 8 * h2 + 4);
            qn += bf2f(qw.x & 0xffffu) * n0.x + bf2f(qw.x >> 16) * n0.y + bf2f(qw.y & 0xffffu) * n0.z + bf2f(qw.y >> 16) * n0.w + bf2f(qw.z & 0xffffu) * n1.x + bf2f(qw.z >> 16) * n1.y + bf2f(qw.w & 0xffffu) * n1.z + bf2f(qw.w >> 16) * n1.w; }
        den = sc * qn;
    }
    const int kt0 = 4 * J, my_last = 4 * J + (wave >> 1);
    const int i16 = lane & 15, q = i16 >> 2, p = i16 & 3, blk = (lane >> 4) & 1;
    u32x4 kreg[2], vreg[2]; float breg = 0.f;
#pragma unroll
    for (int i = 0; i < 2; ++i) { const int idx = tid + 512 * i, rw = 64 * kt0 + (idx >> 4), ch = idx & 15; kreg[i] = *(const u32x4*)(KB + (size_t)rw * 512 + ch * 8); vreg[i] = *(const u32x4*)(VB + (size_t)rw * 512 + ch * 8); }
    if (tid < 64) breg = BETA[64 * kt0 + tid];
#pragma unroll 1
    for (int kt = kt0; kt < kt0 + 4; ++kt) {
        __syncthreads();
#pragma unroll
        for (int i = 0; i < 2; ++i) { const int idx = tid + 512 * i, rw = idx >> 4, ch = idx & 15; *(LAS u32x4*)(lds + A_KS + off128(rw, ch)) = kreg[i]; *(LAS u32x4*)(lds + A_VS + off128(rw, ch)) = vreg[i]; }
        if (tid < 64) BS[tid] = breg * LOG2E;
        __syncthreads();
        if (kt + 1 < kt0 + 4) {
#pragma unroll
            for (int i = 0; i < 2; ++i) { const int idx = tid + 512 * i, rw = 64 * (kt + 1) + (idx >> 4), ch = idx & 15; kreg[i] = *(const u32x4*)(KB + (size_t)rw * 512 + ch * 8); vreg[i] = *(const u32x4*)(VB + (size_t)rw * 512 + ch * 8); }
            if (tid < 64) breg = BETA[64 * (kt + 1) + tid];
        }
        if (kt <= my_last) {
            f32x16 S[2];
#pragma unroll
            for (int rb = 0; rb < 2; ++rb) { S[rb] = zero16();
#pragma unroll
                for (int ks = 0; ks < 8; ++ks) { const bf16x8 kf = *(const LAS bf16x8*)(Ks + off128(32 * rb + r, 2 * ks + h2)); S[rb] = MFMA32(kf, qf[ks], S[rb]); } }
            const bool diag = kt == my_last;
#pragma unroll
            for (int rb = 0; rb < 2; ++rb)
#pragma unroll
                for (int rg = 0; rg < 4; ++rg) { const f32x4 bv = *(const LAS f32x4*)(BS + 32 * rb + 8 * rg + 4 * h2);
#pragma unroll
                    for (int i = 0; i < 4; ++i) { const int key = 64 * kt + 32 * rb + 8 * rg + 4 * h2 + i; float w = ex2(al + bv[i]); if (diag && key > t) w = 0.f;
                        const float sv = S[rb][4 * rg + i] * w; S[rb][4 * rg + i] = sv; den += sv; } }
#pragma unroll
            for (int rb = 0; rb < 2; ++rb) {
                const bf16x8 pb0 = pack_step<0>(S[rb]), pb1 = pack_step<1>(S[rb]);
#pragma unroll
                for (int s = 0; s < 2; ++s) { const int rlo = 32 * rb + 16 * s + 4 * h2 + q;
#pragma unroll
                    for (int db = 0; db < 4; ++db) { const int dcol = 32 * db + 16 * blk + 4 * p, ch = dcol >> 3, sub = (dcol & 7) * 2;
                        const s16x4 lo = vtr(Vs + off128(rlo, ch) + sub), hi = vtr(Vs + off128(rlo + 8, ch) + sub);
                        const bf16x8 va = __builtin_shufflevector(lo, hi, 0, 1, 2, 3, 4, 5, 6, 7);
                        O[db] = MFMA32(va, s == 0 ? pb0 : pb1, O[db]); } }
            }
        }
    }
    den += __shfl_xor(den, 32);
    const float inv = 1.f / fmaxf(fabsf(den), __expf(-mt));
    float s1 = 0.f;
#pragma unroll
    for (int db = 0; db < 4; ++db)
#pragma unroll
        for (int reg = 0; reg < 16; ++reg) { O[db][reg] *= inv; s1 += O[db][reg]; }
    s1 += __shfl_xor(s1, 32);
    const float mu = s1 * (1.f / 128.f);
    float s2 = 0.f;
#pragma unroll
    for (int db = 0; db < 4; ++db)
#pragma unroll
        for (int reg = 0; reg < 16; ++reg) { const float dlt = O[db][reg] - mu; s2 += dlt * dlt; }
    s2 += __shfl_xor(s2, 32);
    const float rstd = 1.f / sqrtf(s2 * (1.f / 128.f) + EPS);
    const float* gn = INF(a, I_GNORM) + h * 128; const bf16_t* ob = (const bf16_t*)(ws + WS_OB) + row * 512 + h * 128; bf16_t* op = (bf16_t*)(ws + WS_OAHB) + row * 1024 + 512 + h * 128;
#pragma unroll
    for (int db = 0; db < 4; ++db)
#pragma unroll
        for (int rg = 0; rg < 4; ++rg) { const int dv = 32 * db + 8 * rg + 4 * h2; const f32x4 g4 = *(const f32x4*)(gn + dv), o4 = ld4bf(ob + dv);
            u32x2 w; w.x = pk2((O[db][4 * rg] - mu) * rstd * g4.x * o4.x, (O[db][4 * rg + 1] - mu) * rstd * g4.y * o4.y);
            w.y = pk2((O[db][4 * rg + 2] - mu) * rstd * g4.z * o4.z, (O[db][4 * rg + 3] - mu) * rstd * g4.w * o4.w); *(u32x2*)(op + dv) = w; }
    __syncthreads();
}

DI void mblk_unit(const Args& a, LAS unsigned char* lds, int b, int h, int J) {
    unsigned char* ws = a.ws;
    int tid_ = threadIdx.x; asm volatile("" : "+v"(tid_));
    const int tid = tid_, lane = tid & 63, wave = __builtin_amdgcn_readfirstlane(tid >> 6), h2 = lane >> 5;
    const int seq = b * 4 + h, dkb = wave & 3, dvh = wave >> 2;
    const bf16_t* KB = (const bf16_t*)(ws + WS_KB) + ((size_t)b * T + 256 * J) * 512 + h * 128; const bf16_t* VB = (const bf16_t*)(ws + WS_VB) + ((size_t)b * T + 256 * J) * 512 + h * 128;
    const LAS unsigned char* Ks = lds + A_KS; const LAS unsigned char* Vs = lds + A_VS; LAS float* WL = (LAS float*)(lds + 32768); LAS float* NR = (LAS float*)(lds + 36864);
    const int i16 = lane & 15, q = i16 >> 2, p = i16 & 3, blk = (lane >> 4) & 1;
    __syncthreads();
    if (wave == 0) {
        const float* ga = (const float*)(ws + WS_GA) + ((size_t)b * T + 256 * J + lane) * 32;
        float ipv[4], bl[4];
#pragma unroll
        for (int c = 0; c < 4; ++c) { ipv[c] = ga[(size_t)c * 64 * 32 + 24 + h]; bl[c] = ga[(size_t)c * 64 * 32 + 28 + h]; }
        float Bc = 0.f;
#pragma unroll
        for (int c = 0; c < 4; ++c) { const float fp = bl[c]; float lf = fminf(fp, 0.f) - log1pf(__expf(-fabsf(fp)));
#pragma unroll
            for (int o = 1; o < 64; o <<= 1) { const float u = __shfl_up(lf, o); if (lane >= o) lf += u; }
            bl[c] = Bc + lf; Bc = __shfl(bl[c], 63); }
        float mx = -INFINITY;
#pragma unroll
        for (int c = 0; c < 4; ++c) { ipv[c] = Bc - bl[c] + ipv[c]; mx = fmaxf(mx, ipv[c]); }
        mx = wave_max(mx);
#pragma unroll
        for (int c = 0; c < 4; ++c) WL[64 * c + lane] = __expf(ipv[c] - mx);
        if (lane == 0) ((float*)(ws + WS_MU))[seq * 8 + J] = mx;
    }
    f32x16 acc[2]; acc[0] = zero16(); acc[1] = zero16();
    float nacc = 0.f; const int ndk = tid & 127, npart = tid >> 7;
    u32x4 kreg[2], vreg[2];
#pragma unroll
    for (int i = 0; i < 2; ++i) { const int idx = tid + 512 * i, rw = idx >> 4, ch = idx & 15; kreg[i] = *(const u32x4*)(KB + (size_t)rw * 512 + ch * 8); vreg[i] = *(const u32x4*)(VB + (size_t)rw * 512 + ch * 8); }
#pragma unroll 1
    for (int kt = 0; kt < 4; ++kt) {
        __syncthreads();
#pragma unroll
        for (int i = 0; i < 2; ++i) { const int idx = tid + 512 * i, rw = idx >> 4, ch = idx & 15; const float w = WL[64 * kt + rw];
            u32x4 k = kreg[i];
            k.x = pk2(bf2f(k.x & 0xffffu) * w, bf2f(k.x >> 16) * w); k.y = pk2(bf2f(k.y & 0xffffu) * w, bf2f(k.y >> 16) * w); k.z = pk2(bf2f(k.z & 0xffffu) * w, bf2f(k.z >> 16) * w); k.w = pk2(bf2f(k.w & 0xffffu) * w, bf2f(k.w >> 16) * w);
            *(LAS u32x4*)(lds + A_KS + off128(rw, ch)) = k; *(LAS u32x4*)(lds + A_VS + off128(rw, ch)) = vreg[i]; }
        __syncthreads();
        if (kt + 1 < 4) {
#pragma unroll
            for (int i = 0; i < 2; ++i) { const int idx = tid + 512 * i, rw = 64 * (kt + 1) + (idx >> 4), ch = idx & 15; kreg[i] = *(const u32x4*)(KB + (size_t)rw * 512 + ch * 8); vreg[i] = *(const u32x4*)(VB + (size_t)rw * 512 + ch * 8); }
        }
#pragma unroll
        for (int i = 0; i < 16; ++i) { const int rw = npart * 16 + i; nacc += bf2f(*(const LAS unsigned short*)(Ks + off128(rw, ndk >> 3) + (ndk & 7) * 2)); }
#pragma unroll
        for (int ss = 0; ss < 4; ++ss) { const int rlo = 16 * ss + 8 * h2 + q;
            const int kcol = 32 * dkb + 16 * blk + 4 * p, kch = kcol >> 3, ksub = (kcol & 7) * 2;
            const s16x4 klo = vtr(Ks + off128(rlo, kch) + ksub), khi = vtr(Ks + off128(rlo + 4, kch) + ksub);
            const bf16x8 ka = __builtin_shufflevector(klo, khi, 0, 1, 2, 3, 4, 5, 6, 7);
#pragma unroll
            for (int e = 0; e < 2; ++e) { const int vcol = 32 * (2 * dvh + e) + 16 * blk + 4 * p, vch = vcol >> 3, vsub = (vcol & 7) * 2;
                const s16x4 vlo = vtr(Vs + off128(rlo, vch) + vsub), vhi = vtr(Vs + off128(rlo + 4, vch) + vsub);
                const bf16x8 vbf = __builtin_shufflevector(vlo, vhi, 0, 1, 2, 3, 4, 5, 6, 7);
                acc[e] = MFMA32(ka, vbf, acc[e]); } }
    }
    float* co = (float*)(ws + WS_DC) + (size_t)(seq * 8 + J) * 16384;
#pragma unroll
    for (int e = 0; e < 2; ++e)
#pragma unroll
        for (int reg = 0; reg < 16; ++reg) co[(size_t)(32 * dkb + crow(reg, h2)) * 128 + 32 * (2 * dvh + e) + (lane & 31)] = acc[e][reg];
    __syncthreads();
    NR[npart * 128 + ndk] = nacc;
    __syncthreads();
    if (tid < 128) ((float*)(ws + WS_DN))[(seq * 8 + J) * 128 + tid] = (NR[tid] + NR[128 + tid]) + (NR[256 + tid] + NR[384 + tid]);
    __syncthreads();
}
DI void mfin_unit(const Args& a, LAS unsigned char* lds, int seq) {
    unsigned char* ws = a.ws;
    const int tid = threadIdx.x;
    LAS float* KAP = (LAS float*)(lds + M_KAP);
    const float* ALPHA = (const float*)(ws + WS_ALPHA) + seq * 2048; const float* MTG = (const float*)(ws + WS_MT) + seq * 2048;
    __syncthreads();
    if (tid < 8) { const int ep = 256 * tid + 255; const float Bl = ALPHA[2047] + MTG[2047], Bep = ALPHA[ep] + MTG[ep];
        KAP[tid] = __expf((Bl - Bep) + ((const float*)(ws + WS_MU))[seq * 8 + tid] - MTG[2047]); }
    __syncthreads();
    f32x4 cacc[8];
#pragma unroll
    for (int i = 0; i < 8; ++i) cacc[i] = (f32x4){0.f, 0.f, 0.f, 0.f};
    float nacc = 0.f;
    const float* dc = (const float*)(ws + WS_DC) + (size_t)seq * 8 * 16384 + tid * 4; const float* dn = (const float*)(ws + WS_DN) + seq * 8 * 128;
#pragma unroll 1
    for (int jp = 0; jp < 8; ++jp) { const float f = KAP[jp];
#pragma unroll
        for (int i = 0; i < 8; ++i) cacc[i] = cacc[i] + *(const f32x4*)(dc + (size_t)jp * 16384 + 2048 * i) * f;
        if (tid < 128) nacc += dn[jp * 128 + tid] * f; }
    float* co = a.out + O_CP + (size_t)seq * 16384 + tid * 4;
#pragma unroll
    for (int i = 0; i < 8; ++i) *(f32x4*)(co + 2048 * i) = cacc[i];
    if (tid < 128) a.out[O_NP + seq * 128 + tid] = nacc;
    __syncthreads();
}
constexpr int S_SC = 0, S_VP = 16384, S_Q = 24576, S_RED = 25600, S_OB = 58368, S_IMP = 61440, S_SEL = 62720;
DI void snsa_softmax(LAS float* SC, int n, int wave, int lane) {
    if (wave < 4) { LAS float* sc = SC + wave * 1024; float mx = -INFINITY;
        for (int k = lane; k < n; k += 64) mx = fmaxf(mx, sc[k]);
        mx = wave_max(mx); const float ms = mx == -INFINITY ? 0.f : mx; float sm = 0.f;
        for (int k = lane; k < n; k += 64) { const float p = ex2(sc[k] - ms); sc[k] = p; sm += p; }
        sm = wave_sum(sm); const float inv = sm > 0.f ? 1.f / fmaxf(sm, 1e-30f) : 0.f;
        for (int k = lane; k < n; k += 64) sc[k] *= inv; }
}
DI void snsa_key(const Args& a, int br, int kk, int s, int g, const LAS int* SEL, const int* pt, const float*& kp, const float*& vp, int& dist, bool& valid) {
    valid = true;
    if (br == 1) { const int pos = SEL[kk >> 6] * 64 + (kk & 63); dist = PAST - pos; valid = pos <= PAST;
        if (pos < PAST) { const float* base = INF(a, I_CKV) + ((size_t)pt[pos >> 7] * PAGE + (pos & 127)) * 512; kp = base + 256 + g * 64; vp = base + 384 + g * 64; }
        else { const float* base = a.out + O_KVS + (size_t)s * 512; kp = base + 256 + g * 64; vp = base + 384 + g * 64; } }
    else { const int w = kk + 1; dist = 511 - kk;
        const float* base = w < 512 ? INF(a, I_CWIN) + ((size_t)s * 512 + w) * 256 : a.out + O_WINS + ((size_t)s * 512 + 511) * 256; kp = base + g * 64; vp = base + 128 + g * 64; }
}
DI void snsa_unit(const Args& a, LAS unsigned char* lds, int s, int g) {
    unsigned char* ws = a.ws;
    int tid_ = threadIdx.x; asm volatile("" : "+v"(tid_));
    const int tid = tid_, lane = tid & 63, wave = __builtin_amdgcn_readfirstlane(tid >> 6), ksl = tid >> 4, c16 = tid & 15;
    const size_t row = (size_t)MPR + s;
    LAS float* SC = (LAS float*)(lds + S_SC); LAS unsigned long long* VP = (LAS unsigned long long*)(lds + S_VP); LAS float* Q = (LAS float*)(lds + S_Q); LAS float* RED = (LAS float*)(lds + S_RED);
    LAS float* OBR = (LAS float*)(lds + S_OB); LAS float* IMP = (LAS float*)(lds + S_IMP); LAS int* SEL = (LAS int*)(lds + S_SEL);
    const float* rbias = INF(a, I_RB); const int* pt = (const int*)a.in[I_PT] + s * NPAGES;
    const bf16_t* kcb = (const bf16_t*)(ws + WS_KC) + ((size_t)AROWS_P + (size_t)(s * 2 + g) * 1024) * 64; const bf16_t* vcb = kcb + (size_t)AROWS * 64;
    __syncthreads();
    if (tid < 256) Q[tid] = bf2f(((const bf16_t*)(ws + WS_QA))[row * 512 + g * 256 + tid]);
    __syncthreads();
    f32x4 q4[4];
#pragma unroll
    for (int hq = 0; hq < 4; ++hq) q4[hq] = *(const LAS f32x4*)(Q + hq * 64 + 4 * c16);
    const int myh = 2 * (c16 & 1) + ((c16 >> 1) & 1);
#pragma unroll 1
    for (int br = 0; br < 3; ++br) {
        const int nkeys = br == 0 ? 1023 : (br == 1 ? 1024 : 512);
#pragma unroll 1
        for (int k0 = ksl; k0 < nkeys; k0 += 256) {
            f32x4 x[8]; int dist[8]; bool valid[8];
#pragma unroll
            for (int u = 0; u < 8; ++u) { const int kk = k0 + 32 * u; const int kc = kk < nkeys ? kk : k0;
                if (br == 0) { const u32x2 w = *(const u32x2*)(kcb + (size_t)kc * 64 + 4 * c16); x[u] = (f32x4){bf2f(w.x & 0xffffu), bf2f(w.x >> 16), bf2f(w.y & 0xffffu), bf2f(w.y >> 16)}; dist[u] = 16353 - 16 * kc; valid[u] = true; }
                else { const float* kp; const float* vp; snsa_key(a, br, kc, s, g, SEL, pt, kp, vp, dist[u], valid[u]); x[u] = *(const f32x4*)(kp + 4 * c16); if (c16 == 0 && kk < nkeys) VP[kk] = (unsigned long long)(uintptr_t)vp; } }
#pragma unroll
            for (int u = 0; u < 8; ++u) { const int kk = k0 + 32 * u;
                float p0 = x[u].x * q4[0].x + x[u].y * q4[0].y + x[u].z * q4[0].z + x[u].w * q4[0].w, p1 = x[u].x * q4[1].x + x[u].y * q4[1].y + x[u].z * q4[1].z + x[u].w * q4[1].w;
                float p2 = x[u].x * q4[2].x + x[u].y * q4[2].y + x[u].z * q4[2].z + x[u].w * q4[2].w, p3 = x[u].x * q4[3].x + x[u].y * q4[3].y + x[u].z * q4[3].z + x[u].w * q4[3].w;
                const bool o1 = (c16 & 1) != 0, o2 = (c16 & 2) != 0;
                float ka = o1 ? p2 : p0, kb2 = o1 ? p3 : p1; const float sa = o1 ? p0 : p2, sb = o1 ? p1 : p3;
                ka += __shfl_xor(sa, 1); kb2 += __shfl_xor(sb, 1);
                float e = o2 ? kb2 : ka; const float f = o2 ? ka : kb2;
                e += __shfl_xor(f, 2); e += __shfl_xor(e, 4); e += __shfl_xor(e, 8);
                if (c16 < 4 && kk < nkeys) SC[myh * 1024 + kk] = valid[u] ? e + rbias[rel_bucket(dist[u]) * 8 + g * 4 + myh] * LOG2E : -INFINITY; }
        }
        __syncthreads();
        snsa_softmax(SC, nkeys, wave, lane);
        __syncthreads();
        { f32x4 o[4];
#pragma unroll
          for (int hq = 0; hq < 4; ++hq) o[hq] = (f32x4){0.f, 0.f, 0.f, 0.f};
#pragma unroll 1
          for (int k0 = ksl; k0 < nkeys; k0 += 256) {
              f32x4 v[8];
#pragma unroll
              for (int u = 0; u < 8; ++u) { const int kk = k0 + 32 * u; const int kc = kk < nkeys ? kk : k0;
                  if (br == 0) { const u32x2 w = *(const u32x2*)(vcb + (size_t)kc * 64 + 4 * c16); v[u] = (f32x4){bf2f(w.x & 0xffffu), bf2f(w.x >> 16), bf2f(w.y & 0xffffu), bf2f(w.y >> 16)}; }
                  else v[u] = *(const f32x4*)((const float*)(uintptr_t)VP[kc] + 4 * c16); }
#pragma unroll
              for (int u = 0; u < 8; ++u) { const int kk = k0 + 32 * u; if (kk < nkeys) {
#pragma unroll
                  for (int hq = 0; hq < 4; ++hq) o[hq] = o[hq] + v[u] * SC[hq * 1024 + kk]; } }
          }
#pragma unroll
          for (int hq = 0; hq < 4; ++hq) *(LAS f32x4*)(RED + (ksl * 4 + hq) * 64 + 4 * c16) = o[hq]; }
        if (br == 0) {
            if (tid < 257) { const int j = tid; float im = 0.f; const int i0 = 4 * j - 1 < 0 ? 0 : 4 * j - 1, i1 = 4 * j + 3 > 1022 ? 1022 : 4 * j + 3;
                for (int hq = 0; hq < 4; ++hq) for (int i = i0; i <= i1; ++i) im += SC[hq * 1024 + i];
                IMP[j] = (j == 0 || j >= 255) ? 1e9f : im; }
        }
        __syncthreads();
        if (tid < 256) { float o = 0.f;
#pragma unroll 8
            for (int p32 = 0; p32 < 32; ++p32) o += RED[p32 * 256 + tid]; OBR[br * 256 + tid] = o; }
        if (br == 0 && tid < 257) { const float my = IMP[tid]; int rank = 0;
#pragma unroll 8
            for (int k = 0; k < 257; ++k) { const float o = IMP[k]; rank += (o > my || (o == my && k < tid)) ? 1 : 0; } if (rank < 16) SEL[rank] = tid; }
        __syncthreads();
    }
    if (tid < 256) { const int hq = tid >> 6; const float* ga = (const float*)(ws + WS_GA) + row * 32 + (g * 4 + hq) * 3;
        const float o = ga[0] * OBR[tid] + ga[1] * OBR[256 + tid] + ga[2] * OBR[512 + tid];
        ((bf16_t*)(ws + WS_OAHB))[row * 1024 + g * 256 + tid] = (bf16_t)(pk2(o, 0.f) & 0xffffu); }
    __syncthreads();
}
DI void smlstm_unit(const Args& a, LAS unsigned char* lds, int s, int h) {
    unsigned char* ws = a.ws;
    const int tid = threadIdx.x, lane = tid & 63, dv = tid & 127, part = tid >> 7;
    const size_t row = (size_t)MPR + s; const int sh = s * 4 + h;
    LAS float* QF = (LAS float*)lds; LAS float* KF = QF + 128; LAS float* VF = QF + 256; LAS float* RED = QF + 384; LAS float* HV = QF + 896; LAS float* SCL = QF + 1024;
    const float* C0 = INF(a, I_SC) + (size_t)sh * 16384; const float* n0 = INF(a, I_SN) + sh * 128;
    __syncthreads();
    if (tid < 128) { QF[tid] = bf2f(((const bf16_t*)(ws + WS_QB))[row * 512 + h * 128 + tid]); KF[tid] = bf2f(((const bf16_t*)(ws + WS_KB))[row * 512 + h * 128 + tid]); VF[tid] = bf2f(((const bf16_t*)(ws + WS_VB))[row * 512 + h * 128 + tid]); }
    __syncthreads();
    if (tid < 64) { const float qk = wave_sum(QF[lane] * KF[lane] + QF[lane + 64] * KF[lane + 64]); const float qn = wave_sum(QF[lane] * n0[lane] + QF[lane + 64] * n0[lane + 64]);
        if (lane == 0) { SCL[0] = qk; SCL[1] = qn; } }
    const float* gr = (const float*)(ws + WS_GA) + row * 32; const float ip = gr[24 + h], fp = gr[28 + h], m0 = INF(a, I_SM)[sh];
    const float lf = fminf(fp, 0.f) - log1pf(__expf(-fabsf(fp))), ain = lf + m0, mt = fmaxf(ain, ip), w_in = __expf(ain - mt), wi = __expf(ip - mt);
    __syncthreads();
    float num = 0.f; float* Co = a.out + O_CS + (size_t)sh * 16384; const float vv = VF[dv];
    { float c0v[32];
#pragma unroll
      for (int i = 0; i < 32; ++i) c0v[i] = C0[(size_t)(part * 32 + i) * 128 + dv];
#pragma unroll
      for (int i = 0; i < 32; ++i) { const int dk = part * 32 + i; num += QF[dk] * c0v[i]; Co[(size_t)dk * 128 + dv] = w_in * c0v[i] + wi * KF[dk] * vv; } }
    RED[part * 128 + dv] = num;
    __syncthreads();
    if (tid < 128) { const float nt = (RED[dv] + RED[128 + dv]) + (RED[256 + dv] + RED[384 + dv]); const float sw = SCL[0] * wi; const float den = w_in * SCL[1] + sw;
        HV[dv] = (w_in * nt + sw * vv) / fmaxf(fabsf(den), __expf(-mt));
        a.out[O_NS + sh * 128 + dv] = w_in * n0[dv] + wi * KF[dv];
        if (tid == 0) a.out[O_MS + sh] = mt; }
    __syncthreads();
    if (tid < 128) { float s1 = 0.f; for (int i = 0; i < 128; ++i) s1 += HV[i]; const float mu = s1 * (1.f / 128.f); float s2 = 0.f; for (int i = 0; i < 128; ++i) { const float dl = HV[i] - mu; s2 += dl * dl; }
        const float rstd = 1.f / sqrtf(s2 * (1.f / 128.f) + EPS);
        const float o = (HV[dv] - mu) * rstd * INF(a, I_GNORM)[h * 128 + dv] * bf2f(((const bf16_t*)(ws + WS_OB))[row * 512 + h * 128 + dv]);
        ((bf16_t*)(ws + WS_OAHB))[row * 1024 + 512 + h * 128 + dv] = (bf16_t)(pk2(o, 0.f) & 0xffffu); }
    __syncthreads();
}

constexpr int NU_TOTAL = 992;
#ifndef DUP_MASK
#define DUP_MASK 0
#endif
#ifndef P4F_A
#define P4F_A 1
#endif
#ifndef P4F_B
#define P4F_B 1
#endif
#ifndef P4F_C
#define P4F_C 1
#endif
DI void p4_run(const Args& a, LAS unsigned char* lds, unsigned* qctr, const XcdBarrier& fb, unsigned* F, unsigned* F2, unsigned* F4a, unsigned* F4b) {
    const int tid = threadIdx.x, lane = tid & 63, wave = __builtin_amdgcn_readfirstlane(tid >> 6);
    LAS int* UQ = (LAS int*)(lds + RING_BYTES + 64);
    int u;
#define NEXT_UNIT4() do { __syncthreads(); if (tid == 0) *UQ = (int)__hip_atomic_fetch_add(qctr, 1u, __ATOMIC_RELAXED, __HIP_MEMORY_SCOPE_AGENT); __syncthreads(); u = __builtin_amdgcn_readfirstlane(*UQ); } while (0)
    if (tid == 0) *(volatile LAS int*)(lds + RING_BYTES + 192) = 0;
    if (F2 != nullptr) xcd_flag_wait(fb, F2);
    NEXT_UNIT4();
    constexpr int CS = 32, C0 = CS + 128 * P4F_A, C1 = C0 + 256 * P4F_B, C2 = C1, C3 = C2 + 256 * P4F_C;
#pragma unroll 1
    while (u < CS) { if (wave == 0) scan_unit(a, u, lane); NEXT_UNIT4(); }
#pragma unroll 1
    while (u < C0) { const int v = (u - CS) % 128; pcmp_unit(a, lds, v >> 6, (v >> 2) & 15, v & 3, wave, lane); NEXT_UNIT4(); }
#pragma unroll 1
    while (u < C1) { const int v = (u - C0) % 256; mblk_unit(a, lds, v >> 5, (v >> 3) & 3, v & 7); NEXT_UNIT4(); }
    if (F4a != nullptr) xcd_flag_arrive(fb, F4a);
    if (F != nullptr && u < C3) { w2_stage(a, lds, tid); xcd_flag_wait(fb, F); }
#pragma unroll 1
    while (u < C3) { const int v = (u - C2) % 256; w2_unit(a, lds, v, wave, lane); NEXT_UNIT4(); }
    if (F4b != nullptr) xcd_flag_arrive(fb, F4b);
#undef NEXT_UNIT4
}
DI void p5_run(const Args& a, LAS unsigned char* lds, unsigned* qctr, const XcdBarrier& fb, unsigned* F4a, unsigned* F4b) {
    const int tid = threadIdx.x;
    if (F4a != nullptr) xcd_flag_wait(fb, F4a);
        LAS int* UQ = (LAS int*)(lds + RING_BYTES + 64);
        int u;
#ifndef UNIT_MASK
#define UNIT_MASK 31
#endif
#define NEXT_UNIT() do { __syncthreads(); if (tid == 0) *UQ = (int)__hip_atomic_fetch_add(qctr, 1u, __ATOMIC_RELAXED, __HIP_MEMORY_SCOPE_AGENT); __syncthreads(); u = __builtin_amdgcn_readfirstlane(*UQ); } while (0)
        if (tid == 0) { ((volatile LAS int*)(lds + RING_BYTES + 128))[0] = 0; ((volatile LAS int*)(lds + RING_BYTES + 128))[1] = 0; }
        NEXT_UNIT();
#ifndef F_ST
#define F_ST 1
#endif
#ifndef F_ML
#define F_ML 1
#endif
#ifndef F_NSA
#define F_NSA 1
#endif
#ifndef F_SN
#define F_SN 1
#endif
#ifndef F_SM
#define F_SM 1
#endif
        constexpr int B0 = 64 * F_SN, B1 = B0 + 32 * F_ST, B2 = B1 + 512 * F_NSA, B3 = B2 + 256 * F_ML, B4 = B3 + 128 * F_SM;
        if (F4b != nullptr && u < B0) xcd_flag_wait(fb, F4b);
#pragma unroll 1
        while (u < B0) { const int v = u % 64; snsa_unit(a, lds, v >> 1, v & 1); NEXT_UNIT(); }
#pragma unroll 1
        while (u < B1) { const int v = (u - B0) % 32; mfin_unit(a, lds, v); NEXT_UNIT(); }
#pragma unroll 1
        while (u < B2) { const int v = (u - B1) % 512; nsa_unit(a, lds, (v & 15) >> 1, v & 1, 31 - (v >> 4)); NEXT_UNIT(); }
#pragma unroll 1
        while (u < B3) { const int v = (u - B2) % 256; mlstm_unit(a, lds, (v & 31) >> 2, v & 3, 7 - (v >> 5)); NEXT_UNIT(); }
#pragma unroll 1
        while (u < B4) { const int v = (u - B3) % 128; smlstm_unit(a, lds, v >> 2, v & 3); NEXT_UNIT(); }
#undef NEXT_UNIT
}
constexpr int NPH = 12;
__global__ void __launch_bounds__(NWAVES * 64, 2) fwd(Args a) {
    extern __shared__ __attribute__((aligned(16))) unsigned char lds_raw[];
    LAS unsigned char* lds = (LAS unsigned char*)lds_raw;
    const int tid = threadIdx.x, lane = tid & 63, wave = __builtin_amdgcn_readfirstlane(tid >> 6);
    const int G = gridDim.x; const int bx = blockIdx.x; const int vcu = (G % 8 == 0) ? (bx % 8) * (G / 8) + bx / 8 : bx;
    const int gw = vcu * NWAVES + wave, NGW = G * NWAVES;
    unsigned char* ws = a.ws;
    unsigned* ctl = (unsigned*)(ws + WS_CTL);
    volatile LAS unsigned* MISC = (volatile LAS unsigned*)(lds + MISC_OFF);
    for (int u = tid; u < (LDS_BYTES - RING_BYTES) / 4; u += NWAVES * 64) ((LAS unsigned*)(lds + RING_BYTES))[u] = 0u;
    __syncthreads();
    const int lo = a.ph_lo & 255, hi = a.ph_hi, qsel = a.ph_lo >> 8;
    const bool use_bar = (hi - lo) > 1;
    XcdBarrier bar; bar.bar = ctl + CW_BAR; bar.x = 0; bar.st = nullptr;
    if (use_bar) bar = xcd_barrier_post(ctl + CW_BAR, MISC + 8);
#ifndef PH_MASK
#define PH_MASK 0xFFF
#endif
#define IN(k) ((((PH_MASK) >> (k)) & 1) && lo <= (k) && (k) < hi)
#define SEAM(k) do { if (IN(k) && IN((k) + 1)) { if ((k) == 0) xcd_barrier(bar); else { xcd_flag_arrive(bar, ctl + CW_SEAMF + 4096 * (k)); xcd_flag_wait(bar, ctl + CW_SEAMF + 4096 * (k)); } } } while (0)
#ifndef DUP_MASK
#define DUP_MASK 0
#endif
#ifndef DUPB_MASK
#define DUPB_MASK 0
#endif
#define REP(k) _Pragma("unroll 1") for (int rep = 0; rep < 1 + ((((DUP_MASK) | (DUPB_MASK)) >> (k)) & 1); ++rep)
#define REPB(k) do { if ((((DUPB_MASK) >> (k)) & 1) && rep == 0) xcd_barrier(bar); } while (0)

#ifndef XBAR
#define XBAR 0
#endif
    if (IN(0)) { REP(0) { p0_prologue(a, lds, gw, NGW, wave, lane); REPB(0); } } SEAM(0);
    if (use_bar) { _Pragma("unroll 1") for (int xb = 0; xb < XBAR; ++xb) xcd_barrier(bar); }
    if (IN(1)) { REP(1) { norm_phase_bf16(a, 0, gw, NGW, lane); late_transposes<2>(a, lds, NGW - 1 - gw, NGW, wave, lane); REPB(1); } } SEAM(1);
    if (IN(2)) { REP(2) {
        pg8::Gemm g{(const bf16_t*)(ws + WS_U), (const bf16_t*)(ws + WS_WIN_T), MPR, NZ, 1024, 1024}; pg8::StaticOrder S; S.init(MPR, NZ, G, bx);
        EpiZ E{(bf16_t*)(ws + WS_QA), (bf16_t*)(ws + WS_KVB), (bf16_t*)(ws + WS_QB), (bf16_t*)(ws + WS_KB), (bf16_t*)(ws + WS_VB), (bf16_t*)(ws + WS_OB), (bf16_t*)(ws + WS_GM), (bf16_t*)(ws + WS_ABF), (float*)(ws + WS_GA), a.out, INF(a, I_GATEB)};
        pg8::gemm_phase<EpiZ>(lds, g, S, E);
        skinny_phase<EpiZ>(lds, g.A, 1024, g.Bt, 1024, NZ, S.nwg, E, bx, G, wave, lane);
        { const int rem_ = S.nwg % G, nl_ = rem_ ? G - rem_ : G, me_ = G - 1 - bx; if (me_ < nl_) { late_transposes<0>(a, lds, me_ * NWAVES + wave, nl_ * NWAVES, wave, lane); if (me_ >= nl_ - 8) cbias_task(a, lds, nl_ - 1 - me_, wave, lane); } }
        REPB(2); }
    }
    const bool p234 = use_bar && IN(2) && IN(3) && IN(4);
    if (p234) xcd_flag_arrive(bar, ctl + CW_FLAG2); else SEAM(2);
    if (IN(3)) { REP(3) {
            pg8::CacheGemm g{INF(a, I_CKV), (const int*)a.in[I_PT], (const bf16_t*)(ws + WS_W1P_T), 0}; pg8::StaticOrder S; S.init(2 * AROWS_S, 1024, G, bx);
            EpiHid E{(bf16_t*)(ws + WS_GH), (bf16_t*)(ws + WS_GH) + (size_t)2 * AROWS_S * 256};
            pg8::gemm_phase_cache<EpiHid>(lds, g, S, E);
            REPB(3);
        }
    }
    const bool p45 = use_bar && IN(4) && IN(5) && DUP_MASK == 0 && DUPB_MASK == 0;
    const bool p34 = use_bar && IN(3) && IN(4);
    if (p34) xcd_flag_arrive(bar, ctl + CW_FLAG); else SEAM(3);
    if (IN(4)) { REP(4) { p4_run(a, lds, ctl + CW_QUEUE + 128 + 64 * (rep + qsel), bar, p34 ? ctl + CW_FLAG : nullptr, p234 ? ctl + CW_FLAG2 : nullptr, p45 ? ctl + CW_SEAMF + 4096 * 11 : nullptr, p45 ? ctl + CW_SEAMF + 4096 * 12 : nullptr); REPB(4); } }
    if (!p45) SEAM(4);
    if (IN(5)) { p5_run(a, lds, ctl + CW_QUEUE + 64 * qsel, bar, p45 ? ctl + CW_SEAMF + 4096 * 11 : nullptr, p45 ? ctl + CW_SEAMF + 4096 * 12 : nullptr); if ((DUPB_MASK >> 5) & 1) { xcd_barrier(bar); p5_run(a, lds, ctl + CW_QUEUE + 64, bar, nullptr, nullptr); } } SEAM(5);
    if (IN(6)) { REP(6) {
        pg8::Gemm g{(const bf16_t*)(ws + WS_OAHB), (const bf16_t*)(ws + WS_WBR_T), MPR, 1024, 1024, 1024}; pg8::StaticOrder S; S.init(MPR, 1024, G, bx);
        EpiBr E{(const bf16_t*)(ws + WS_GM), (bf16_t*)(ws + WS_MIX)};
        pg8::gemm_phase<EpiBr>(lds, g, S, E);
        skinny_phase<EpiBr>(lds, g.A, 1024, g.Bt, 1024, 1024, S.nwg, E, bx, G, wave, lane); }
    } SEAM(6);
    if (IN(7)) { REP(7) {
        pg8::Gemm g{(const bf16_t*)(ws + WS_MIX), (const bf16_t*)(ws + WS_WOUT_T), MPR, 1024, 1024, 1024}; pg8::StaticOrder S; S.init(MPR, 1024, G, bx);
        EpiRes E{INF(a, I_XP), INF(a, I_XS), (bf16_t*)(ws + WS_X1), (const float*)(ws + WS_MOD), 2 * 1024, nullptr};
        pg8::gemm_phase<EpiRes>(lds, g, S, E);
        skinny_phase<EpiRes>(lds, g.A, 1024, g.Bt, 1024, 1024, S.nwg, E, bx, G, wave, lane); }
    } SEAM(7);
    if (IN(8)) { REP(8) { norm_phase_bf16(a, 1, gw, NGW, lane); REPB(8); } } SEAM(8);
    if (IN(9)) { REP(9) {
        pg8::Gemm g{(const bf16_t*)(ws + WS_U), (const bf16_t*)(ws + WS_WFI_T), MPR, NFF, 1024, 1024}; pg8::StaticOrder S; S.init(MPR, NFF, G, bx);
        EpiSwiGLU E{(bf16_t*)(ws + WS_H)};
        pg8::gemm_phase<EpiSwiGLU>(lds, g, S, E);
        skinny_phase<EpiSwiGLU>(lds, g.A, 1024, g.Bt, 1024, NFF, S.nwg, E, bx, G, wave, lane);
        { const int rem_ = S.nwg % G, nl_ = rem_ ? G - rem_ : G, me_ = G - 1 - bx; if (me_ < nl_) { win_copy(a, me_ * NWAVES + wave, nl_ * NWAVES, lane); late_transposes<1>(a, lds, me_ * NWAVES + wave, nl_ * NWAVES, wave, lane); } }
        REPB(9); }
    } SEAM(9);
    if (IN(10)) { REP(10) {
        pg8::Gemm g{(const bf16_t*)(ws + WS_H), (const bf16_t*)(ws + WS_WFO_T), MPR, 1024, FFH, FFH}; pg8::StaticOrder S; S.init(MPR, 1024, G, bx);
        EpiRes E{INF(a, I_XP), INF(a, I_XS), (bf16_t*)(ws + WS_X2), (const float*)(ws + WS_MOD), 5 * 1024, (const bf16_t*)(ws + WS_X1)};
        pg8::gemm_phase<EpiRes>(lds, g, S, E);
        skinny_phase<EpiRes>(lds, g.A, FFH, g.Bt, FFH, 1024, S.nwg, E, bx, G, wave, lane); REPB(10); }
    } SEAM(10);
    if (IN(11)) { REP(11) { final_norm_phase(a, gw, NGW, lane); REPB(11); } }
#undef IN
#undef SEAM
}

#ifndef MK_SPLIT
#define MK_SPLIT 0
#endif
extern "C" void kernel_launch(void* const* d_in, const int* in_sizes, int n_in, void* d_out, int out_size, void* d_ws, size_t ws_size, hipStream_t stream) {
    static int grid = 0;
    if (grid == 0) {
        if (n_in != N_INPUTS || (size_t)out_size != O_END || ws_size < WS_END) { fprintf(stderr, "kernel_launch: unexpected shapes: n_in %d out %d ws %zu (need %zu)\n", n_in, out_size, ws_size, (size_t)WS_END); grid = -1; return; }
        int dev = 0, cus = 0, per_cu = 0;
        if (hipGetDevice(&dev) != hipSuccess || hipDeviceGetAttribute(&cus, hipDeviceAttributeMultiprocessorCount, dev) != hipSuccess) { grid = -1; return; }
        if (hipFuncSetAttribute((const void*)fwd, hipFuncAttributeMaxDynamicSharedMemorySize, LDS_BYTES) != hipSuccess) { fprintf(stderr, "kernel_launch: hipFuncSetAttribute failed\n"); grid = -1; return; }
        if (hipOccupancyMaxActiveBlocksPerMultiprocessor(&per_cu, (const void*)fwd, NWAVES * 64, LDS_BYTES) != hipSuccess || per_cu < 1) fprintf(stderr, "kernel_launch: occupancy query reports %d\n", per_cu);
        (void)hipGetLastError();
        grid = cus;
    }
    if (grid < 0) return;
    if (hipMemsetAsync((char*)d_ws + WS_CTL, 0, CTL_ZERO_BYTES, stream) != hipSuccess) return;
    Args a{};
    for (int i = 0; i < N_INPUTS; ++i) a.in[i] = d_in[i];
    a.out = (float*)d_out; a.ws = (unsigned char*)d_ws;
#if MK_SPLIT
#ifndef DUPKM
#define DUPKM 0
#endif
    for (int p = 0; p < NPH; ++p) { a.ph_lo = p; a.ph_hi = p + 1; for (int rep = 0; rep < (((DUPKM >> p) & 1) ? 2 : 1); ++rep) { a.ph_lo = p | (rep << 8); hipLaunchKernelGGL(fwd, dim3(grid), dim3(NWAVES * 64), LDS_BYTES, stream, a); } }
#else
    a.ph_lo = 0; a.ph_hi = NPH; hipLaunchKernelGGL(fwd, dim3(grid), dim3(NWAVES * 64), LDS_BYTES, stream, a);
#endif
    const hipError_t le = hipPeekAtLastError();
    if (le != hipSuccess) fprintf(stderr, "kernel_launch: launch failed: %s\n", hipGetErrorName(le));
}
```
